# Optimizing an MI355X kernel written in HIP

```python
import math
import jax, jax.numpy as jnp
from jax import lax
import numpy as np

D_MODEL = 1024
BATCH = 8
SEQ = 4096
DEPTH = 1

HY_WIDTH = 512
HY_ORDER = 2
SHORT_CONV = 3
FILTER_EMB = 33
FILTER_HIDDEN = 64
DECAY_TARGET = 1e-2
FAST_DECAY = 0.3
SLOW_DECAY = 1.5
MIN_DECAY = math.log(DECAY_TARGET) / SLOW_DECAY
MAX_DECAY = math.log(DECAY_TARGET) / FAST_DECAY

MLA_HEADS = 8
QK_NOPE = 64
QK_ROPE = 32
QK_DIM = QK_NOPE + QK_ROPE
V_DIM = 64
Q_LORA = 384
KV_LORA = 256
ATTN_WIDTH = MLA_HEADS * V_DIM
ROPE_THETA = 10000.0
Q_BLOCK = 128

EPS = 1e-6
IN_COLS = 4 * HY_WIDTH + Q_LORA + KV_LORA + QK_ROPE + ATTN_WIDTH + 2 * D_MODEL

kernel_name = 'hyena_mla_gated_parallel_encoder'


def rms_norm(x, g):
    xf = x.astype(jnp.float32)
    y = xf * lax.rsqrt(jnp.mean(xf * xf, axis=-1, keepdims=True) + EPS)
    return (y * g.astype(jnp.float32)).astype(x.dtype)


def short_conv(u, w, b):
    L = u.shape[1]
    pad = SHORT_CONV // 2
    up = jnp.pad(u, ((0, 0), (pad, pad), (0, 0)))
    return sum(up[:, j:j + L] * w[j] for j in range(SHORT_CONV)) + b


def hyena_filter_spectra(L, w_f1, b_f1, freq_1, w_f2, b_f2, freq_2, w_f3):
    t = jnp.linspace(0.0, 1.0, L, dtype=jnp.float32)[:, None]
    bands = (FILTER_EMB - 1) // 2
    f = jnp.linspace(1e-4, bands - 1, bands, dtype=jnp.float32)
    ang = (2.0 * jnp.pi / L) * jnp.arange(L, dtype=jnp.float32)[:, None] * f[None, :]
    z = jnp.concatenate([t, jnp.cos(ang), -jnp.sin(ang)], axis=-1)
    h = jnp.sin(freq_1 * (z @ w_f1 + b_f1))
    h = jnp.sin(freq_2 * (h @ w_f2 + b_f2))
    k = (h @ w_f3).reshape(L, HY_ORDER, 2, HY_WIDTH)
    deltas = jnp.abs(jnp.linspace(MIN_DECAY, MAX_DECAY, HY_WIDTH, dtype=jnp.float32))
    decay = jnp.exp(-t * deltas)
    k = k * decay[:, None, None, :]
    k_full = jnp.concatenate([k[:, :, 0], k[::-1, :, 1]], axis=0)
    return jnp.fft.rfft(k_full.astype(jnp.float32), axis=0)


def long_conv(u, k_spec, bias):
    L = u.shape[1]
    uf = u.astype(jnp.float32)
    y = jnp.fft.irfft(jnp.fft.rfft(uf, n=2 * L, axis=1) * k_spec[None], n=2 * L, axis=1)[:, :L]
    return (y + uf * bias.astype(jnp.float32)).astype(u.dtype)


def rotary(t, cos, sin):
    t1, t2 = jnp.split(t, 2, axis=-1)
    c = cos[:, None, :].astype(t.dtype)
    s = sin[:, None, :].astype(t.dtype)
    return jnp.concatenate([t1 * c - t2 * s, t1 * s + t2 * c], axis=-1)


def dense_bidirectional_attention(q, k, v):
    B, L, H, Dk = q.shape
    nb = L // Q_BLOCK
    scale = 1.0 / math.sqrt(Dk)
    kt = k.transpose(0, 2, 1, 3)
    vt = v.transpose(0, 2, 1, 3)
    qb = q.reshape(B, nb, Q_BLOCK, H, Dk).transpose(1, 0, 3, 2, 4)

    def one_block(qblk):
        s = jnp.einsum('bhqd,bhkd->bhqk', qblk, kt).astype(jnp.float32) * scale
        p = jax.nn.softmax(s, axis=-1).astype(vt.dtype)
        return jnp.einsum('bhqk,bhkd->bqhd', p, vt)

    o = lax.map(one_block, qb)
    return o.transpose(1, 0, 2, 3, 4).reshape(B, L, H * v.shape[-1])


def setup_inputs(seed: int = 0) -> dict:
    key = jax.random.key(seed)
    ks = jax.random.split(key, 24)
    f32 = jnp.float32

    def nrm(k, shape, scale):
        return jax.random.normal(k, shape, f32) * scale

    n = DEPTH
    return {
        'x': nrm(ks[0], (BATCH, SEQ, D_MODEL), 1.0),
        'g_norm': 1.0 + nrm(ks[1], (n, D_MODEL), 0.02),
        'w_in': nrm(ks[2], (n, D_MODEL, IN_COLS), D_MODEL ** -0.5),
        'b_gate': nrm(ks[3], (n, 2 * D_MODEL), 0.02),
        'w_short': nrm(ks[4], (n, SHORT_CONV, 3 * HY_WIDTH), SHORT_CONV ** -0.5),
        'b_short': nrm(ks[5], (n, 3 * HY_WIDTH), 0.02),
        'w_f1': nrm(ks[6], (n, FILTER_EMB, FILTER_HIDDEN), FILTER_EMB ** -0.5),
        'b_f1': nrm(ks[7], (n, FILTER_HIDDEN), 0.02),
        'freq_1': 1.0 + nrm(ks[8], (n, FILTER_HIDDEN), 0.02),
        'w_f2': nrm(ks[9], (n, FILTER_HIDDEN, FILTER_HIDDEN), FILTER_HIDDEN ** -0.5),
        'b_f2': nrm(ks[10], (n, FILTER_HIDDEN), 0.02),
        'freq_2': 1.0 + nrm(ks[11], (n, FILTER_HIDDEN), 0.02),
        'w_f3': nrm(ks[12], (n, FILTER_HIDDEN, HY_ORDER * 2 * HY_WIDTH), 2.0 * (FILTER_HIDDEN * SEQ) ** -0.5),
        'hy_bias': nrm(ks[13], (n, HY_ORDER, HY_WIDTH), 0.1),
        'w_hy_out': nrm(ks[14], (n, HY_WIDTH, D_MODEL), HY_WIDTH ** -0.5),
        'g_cq': 1.0 + nrm(ks[15], (n, Q_LORA), 0.02),
        'w_uq': nrm(ks[16], (n, Q_LORA, MLA_HEADS * QK_DIM), Q_LORA ** -0.5),
        'g_ckv': 1.0 + nrm(ks[17], (n, KV_LORA), 0.02),
        'w_ukv': nrm(ks[18], (n, KV_LORA, MLA_HEADS * (QK_NOPE + V_DIM)), KV_LORA ** -0.5),
        'g_qn': 1.0 + nrm(ks[19], (n, QK_DIM), 0.02),
        'g_kn': 1.0 + nrm(ks[20], (n, QK_DIM), 0.02),
        'w_attn_out': nrm(ks[21], (n, ATTN_WIDTH, D_MODEL), ATTN_WIDTH ** -0.5),
        'w_out': nrm(ks[22], (n, D_MODEL, D_MODEL), D_MODEL ** -0.5),
    }


def reference(x, g_norm, w_in, b_gate, w_short, b_short, w_f1, b_f1, freq_1, w_f2, b_f2, freq_2,
              w_f3, hy_bias, w_hy_out, g_cq, w_uq, g_ckv, w_ukv, g_qn, g_kn, w_attn_out, w_out):
    B, L, _ = x.shape
    pos = jnp.arange(L, dtype=jnp.float32)
    inv_freq = ROPE_THETA ** (-jnp.arange(0, QK_ROPE, 2, dtype=jnp.float32) / QK_ROPE)
    ang = pos[:, None] * inv_freq[None, :]
    cos, sin = jnp.cos(ang), jnp.sin(ang)

    split_at = list(np.cumsum([3 * HY_WIDTH, HY_WIDTH, Q_LORA, KV_LORA, QK_ROPE, ATTN_WIDTH, D_MODEL]))

    for l in range(DEPTH):
        h = rms_norm(x, g_norm[l])
        proj = h @ w_in[l]
        hy_in, z_hy, c_q, c_kv, k_rope, z_attn, gate_hy, gate_attn = jnp.split(proj, split_at, axis=-1)

        u = short_conv(hy_in, w_short[l], b_short[l])
        v_h, x1, x2 = jnp.split(u, 3, axis=-1)
        k_spec = hyena_filter_spectra(L, w_f1[l], b_f1[l], freq_1[l], w_f2[l], b_f2[l], freq_2[l], w_f3[l])
        zc = v_h
        for o, gate in enumerate((x1, x2)):
            zc = gate * long_conv(zc, k_spec[:, o], hy_bias[l, o])
        u_hy = (zc * jax.nn.silu(z_hy)) @ w_hy_out[l]

        q = (rms_norm(c_q, g_cq[l]) @ w_uq[l]).reshape(B, L, MLA_HEADS, QK_DIM)
        kv = (rms_norm(c_kv, g_ckv[l]) @ w_ukv[l]).reshape(B, L, MLA_HEADS, QK_NOPE + V_DIM)
        k_nope, v_a = kv[..., :QK_NOPE], kv[..., QK_NOPE:]
        k_r = jnp.broadcast_to(k_rope[:, :, None, :], (B, L, MLA_HEADS, QK_ROPE))
        k = jnp.concatenate([k_nope, k_r], axis=-1)
        q = rms_norm(q, g_qn[l])
        k = rms_norm(k, g_kn[l])
        q = jnp.concatenate([q[..., :QK_NOPE], rotary(q[..., QK_NOPE:], cos, sin)], axis=-1)
        k = jnp.concatenate([k[..., :QK_NOPE], rotary(k[..., QK_NOPE:], cos, sin)], axis=-1)
        attn = dense_bidirectional_attention(q, k, v_a)
        u_attn = (attn * jax.nn.silu(z_attn)) @ w_attn_out[l]

        gates = jax.nn.sigmoid(jnp.concatenate([gate_hy, gate_attn], axis=-1) + b_gate[l])
        g_hy, g_at = jnp.split(gates, 2, axis=-1)
        merged = g_hy * u_hy + g_at * u_attn
        x = x + merged @ w_out[l]
    return x
```

```cpp
#include <hip/hip_runtime.h>
#include <cstdio>
#include <cstdint>

typedef unsigned short bfr;
using bf16x8 = __attribute__((ext_vector_type(8))) short;
using f32x4  = __attribute__((ext_vector_type(4))) float;

constexpr int NB = 8, L = 4096, DM = 1024, NTOK = NB * L;
constexpr int HY = 512, INC = 5280, INCP = 5376;
constexpr int P2W = 1184;
constexpr int P2_CQ = 0, P2_CKV = 384, P2_KR = 640, P2_ZA = 672;
constexpr int NH = 8, QKD = 96, KPAD = 128, VD = 64, QL = 384, KVL = 256;
constexpr float EPS = 1e-6f;
constexpr float PI_F = 3.14159265358979323846f;

constexpr size_t al256(size_t x) { return (x + 255) / 256 * 256; }
constexpr size_t OFF_RSTD = 0;
constexpr size_t OFF_ROPE = OFF_RSTD + al256((size_t)NTOK * 4);
constexpr size_t OFF_H2   = OFF_ROPE + al256((size_t)L * 32 * 4);
constexpr size_t OFF_WIN  = OFF_H2 + al256((size_t)L * 64 * 4);
constexpr size_t OFF_WHY  = OFF_WIN + al256((size_t)INCP * DM * 2);
constexpr size_t OFF_WAT  = OFF_WHY + al256((size_t)DM * HY * 2);
constexpr size_t OFF_WOUT = OFF_WAT + al256((size_t)DM * HY * 2);
constexpr size_t OFF_HYT  = OFF_WOUT + al256((size_t)DM * DM * 2);
constexpr size_t OFF_P2   = OFF_HYT + al256((size_t)NB * 2048 * L * 2);
constexpr size_t OFF_Q    = OFF_P2 + al256((size_t)NTOK * P2W * 2);
constexpr size_t OFF_K    = OFF_Q + al256((size_t)NTOK * NH * QKD * 2);
constexpr size_t OFF_V    = OFF_K + al256((size_t)NTOK * NH * KPAD * 2);
constexpr size_t OFF_KF   = OFF_V + al256((size_t)NTOK * NH * VD * 2);
constexpr size_t OFF_AHY  = OFF_KF + al256((size_t)2 * HY * 2 * L * 4);
constexpr size_t OFF_AAT  = OFF_AHY + al256((size_t)NTOK * HY * 2);
constexpr size_t WS_END   = OFF_AAT + al256((size_t)NTOK * HY * 2);
constexpr size_t OFF_XB   = OFF_Q;
constexpr size_t OFF_Z2   = OFF_Q;
constexpr size_t OFF_MRG  = OFF_HYT;

__device__ __forceinline__ bfr f2bf(float x) { unsigned u = __float_as_uint(x); u += 0x7fffu + ((u >> 16) & 1u); return (bfr)(u >> 16); }
__device__ __forceinline__ float bf2f(bfr h) { return __uint_as_float(((unsigned)h) << 16); }
__device__ __forceinline__ float sigmoidf_(float x) { return 1.f / (1.f + __expf(-x)); }
__device__ __forceinline__ float siluf_(float x) { return x / (1.f + __expf(-x)); }

__global__ void k_rope(float* __restrict__ rope) {
  int idx = blockIdx.x * 256 + threadIdx.x;
  int l = idx >> 4, j = idx & 15;
  float inv = powf(10000.f, -(float)(2 * j) / 32.f);
  float ang = (float)l * inv;
  rope[idx * 2] = cosf(ang); rope[idx * 2 + 1] = sinf(ang);
}

__global__ void k_filt_h(const float* __restrict__ w_f1, const float* __restrict__ b_f1, const float* __restrict__ freq1,
                         const float* __restrict__ w_f2, const float* __restrict__ b_f2, const float* __restrict__ freq2,
                         float* __restrict__ H2) {
  __shared__ float z[33]; __shared__ float h1[64];
  int t = blockIdx.x, j = threadIdx.x;
  if (j < 33) {
    float v;
    if (j == 0) v = (float)t / (float)(L - 1);
    else { int i = (j - 1) & 15; float f = 1e-4f + (float)i * ((15.f - 1e-4f) / 15.f); float ang = ((2.f * PI_F / (float)L) * (float)t) * f;
           v = (j <= 16) ? cosf(ang) : -sinf(ang); }
    z[j] = v;
  }
  __syncthreads();
  float a = b_f1[j];
  for (int i = 0; i < 33; ++i) a += z[i] * w_f1[i * 64 + j];
  h1[j] = sinf(freq1[j] * a);
  __syncthreads();
  float c = b_f2[j];
  for (int i = 0; i < 64; ++i) c += h1[i] * w_f2[i * 64 + j];
  H2[t * 64 + j] = sinf(freq2[j] * c);
}

__global__ void k_filt_k(const float* __restrict__ H2, const float* __restrict__ w_f3, float* __restrict__ KF) {
  int t = blockIdx.x * 256 + threadIdx.x; int col = blockIdx.y;
  int o = col >> 10, dir = (col >> 9) & 1, c = col & 511;
  float acc = 0.f;
  for (int j = 0; j < 64; ++j) acc += H2[t * 64 + j] * w_f3[j * 2048 + col];
  const float MIN_DECAY = -3.0701134573253944f, MAX_DECAY = -15.350567286626972f;
  float delta = fabsf(MIN_DECAY + (MAX_DECAY - MIN_DECAY) * ((float)c / 511.f));
  float tl = (float)t / (float)(L - 1);
  KF[((size_t)((o * 512 + c) * 2 + dir)) * L + t] = acc * expf(-tl * delta);
}

__global__ void k_wT(const float* __restrict__ src, const float* __restrict__ scale, bfr* __restrict__ dst, int K, int N, int NP) {
  int n = blockIdx.x * 256 + threadIdx.x; int k = blockIdx.y;
  if (n >= NP) return;
  float v = 0.f;
  if (n < N) { v = src[(size_t)k * N + n]; if (scale) v *= scale[k]; }
  dst[(size_t)n * K + k] = f2bf(v);
}

__global__ void k_rstd_xb(const float* __restrict__ x, bfr* __restrict__ xb, float* __restrict__ rstd) {
  int row = blockIdx.x * 4 + (threadIdx.x >> 6); int lane = threadIdx.x & 63;
  const float4* p = (const float4*)(x + (size_t)row * DM);
  float ss = 0.f;
  for (int i = 0; i < 4; ++i) {
    float4 v = p[lane + 64 * i];
    ss += v.x * v.x + v.y * v.y + v.z * v.z + v.w * v.w;
    ushort4 o; o.x = f2bf(v.x); o.y = f2bf(v.y); o.z = f2bf(v.z); o.w = f2bf(v.w);
    ((ushort4*)(xb + (size_t)row * DM))[lane + 64 * i] = o;
  }
  for (int off = 32; off > 0; off >>= 1) ss += __shfl_xor(ss, off);
  if (lane == 0) rstd[row] = rsqrtf(ss / (float)DM + EPS);
}

__device__ __forceinline__ void gemm_wave_acc(const bfr* __restrict__ A, int lda, const bfr* __restrict__ Bt, int ldb, int K, int m0, int n0, f32x4 (&acc)[2][2]) {
  const int lane = threadIdx.x & 63, r16 = lane & 15, quad = lane >> 4;
  for (int k0 = 0; k0 < K; k0 += 32) {
    bf16x8 a[2], b[2];
    for (int i = 0; i < 2; ++i) a[i] = *(const bf16x8*)(A + (size_t)(m0 + i * 16 + r16) * lda + k0 + quad * 8);
    for (int j = 0; j < 2; ++j) b[j] = *(const bf16x8*)(Bt + (size_t)(n0 + j * 16 + r16) * ldb + k0 + quad * 8);
    for (int i = 0; i < 2; ++i) for (int j = 0; j < 2; ++j) acc[i][j] = __builtin_amdgcn_mfma_f32_16x16x32_bf16(a[i], b[j], acc[i][j], 0, 0, 0);
  }
}

__global__ __launch_bounds__(256) void k_inproj(const bfr* __restrict__ XB, const bfr* __restrict__ WIN, const float* __restrict__ rstd, const float* __restrict__ b_gate,
                                                bfr* __restrict__ HYT, bfr* __restrict__ P2, bfr* __restrict__ GATES) {
  const int wid = threadIdx.x >> 6, lane = threadIdx.x & 63, r16 = lane & 15, quad = lane >> 4;
  const int m0 = blockIdx.y * 64 + (wid >> 1) * 32, n0 = blockIdx.x * 64 + (wid & 1) * 32;
  f32x4 acc[2][2] = {};
  gemm_wave_acc(XB, DM, WIN, DM, DM, m0, n0, acc);
  for (int i = 0; i < 2; ++i) for (int j = 0; j < 2; ++j) for (int e = 0; e < 4; ++e) {
    int row = m0 + i * 16 + quad * 4 + e, col = n0 + j * 16 + r16;
    float v = acc[i][j][e] * rstd[row];
    if (col < 2048) { int b = row >> 12, l = row & 4095; HYT[((size_t)(b * 2048 + col)) * L + l] = f2bf(v); }
    else if (col < 3232) P2[(size_t)row * P2W + (col - 2048)] = f2bf(v);
    else if (col < INC) GATES[(size_t)row * 2048 + (col - 3232)] = f2bf(sigmoidf_(v + b_gate[col - 3232]));
  }
}

__global__ __launch_bounds__(256) void k_q(const bfr* __restrict__ P2, const float* __restrict__ g_cq, const float* __restrict__ w_uq, const float* __restrict__ g_qn,
                                           const float* __restrict__ rope, bfr* __restrict__ Q) {
  const int tok = blockIdx.x * 256 + threadIdx.x, h = blockIdx.y;
  const bfr* p = P2 + (size_t)tok * P2W + P2_CQ;
  float ss = 0.f;
  for (int k = 0; k < QL; ++k) { float a = bf2f(p[k]); ss += a * a; }
  const float rs = rsqrtf(ss / (float)QL + EPS);
  float acc[QKD];
#pragma unroll
  for (int n = 0; n < QKD; ++n) acc[n] = 0.f;
  for (int k = 0; k < QL; ++k) {
    const float a = bf2f(p[k]) * rs * g_cq[k];
    const float* w = w_uq + (size_t)k * (NH * QKD) + h * QKD;
#pragma unroll
    for (int n = 0; n < QKD; ++n) acc[n] += a * w[n];
  }
  float s2 = 0.f;
#pragma unroll
  for (int n = 0; n < QKD; ++n) s2 += acc[n] * acc[n];
  const float r2 = rsqrtf(s2 / (float)QKD + EPS);
#pragma unroll
  for (int n = 0; n < QKD; ++n) acc[n] *= r2 * g_qn[n];
  const int b = tok >> 12, l = tok & 4095;
#pragma unroll
  for (int i = 0; i < 16; ++i) {
    float c = rope[(l * 16 + i) * 2], s = rope[(l * 16 + i) * 2 + 1];
    float t1 = acc[64 + i], t2 = acc[80 + i];
    acc[64 + i] = t1 * c - t2 * s; acc[80 + i] = t1 * s + t2 * c;
  }
  bfr* q = Q + ((size_t)((b * NH + h) * L + l)) * QKD;
#pragma unroll
  for (int n = 0; n < QKD; ++n) q[n] = f2bf(acc[n]);
}

__global__ __launch_bounds__(256) void k_kv(const bfr* __restrict__ P2, const float* __restrict__ g_ckv, const float* __restrict__ w_ukv, const float* __restrict__ g_kn,
                                            const float* __restrict__ rope, bfr* __restrict__ K, bfr* __restrict__ V) {
  const int tok = blockIdx.x * 256 + threadIdx.x, h = blockIdx.y;
  const bfr* p = P2 + (size_t)tok * P2W + P2_CKV;
  float ss = 0.f;
  for (int k = 0; k < KVL; ++k) { float a = bf2f(p[k]); ss += a * a; }
  const float rs = rsqrtf(ss / (float)KVL + EPS);
  float acc[128];
#pragma unroll
  for (int n = 0; n < 128; ++n) acc[n] = 0.f;
  for (int k = 0; k < KVL; ++k) {
    const float a = bf2f(p[k]) * rs * g_ckv[k];
    const float* w = w_ukv + (size_t)k * (NH * 128) + h * 128;
#pragma unroll
    for (int n = 0; n < 128; ++n) acc[n] += a * w[n];
  }
  const int b = tok >> 12, l = tok & 4095;
  const bfr* kr = P2 + (size_t)tok * P2W + P2_KR;
  float kro[32];
#pragma unroll
  for (int i = 0; i < 32; ++i) kro[i] = bf2f(kr[i]);
  float s2 = 0.f;
#pragma unroll
  for (int n = 0; n < 64; ++n) s2 += acc[n] * acc[n];
#pragma unroll
  for (int i = 0; i < 32; ++i) s2 += kro[i] * kro[i];
  const float r2 = rsqrtf(s2 / (float)QKD + EPS);
  bfr* kp = K + ((size_t)((b * NH + h) * L + l)) * KPAD;
#pragma unroll
  for (int n = 0; n < 64; ++n) kp[n] = f2bf(acc[n] * r2 * g_kn[n]);
#pragma unroll
  for (int i = 0; i < 32; ++i) kro[i] *= r2 * g_kn[64 + i];
#pragma unroll
  for (int i = 0; i < 16; ++i) {
    float c = rope[(l * 16 + i) * 2], s = rope[(l * 16 + i) * 2 + 1];
    float t1 = kro[i], t2 = kro[16 + i];
    kp[64 + i] = f2bf(t1 * c - t2 * s); kp[80 + i] = f2bf(t1 * s + t2 * c);
  }
#pragma unroll
  for (int n = 96; n < 128; ++n) kp[n] = 0;
  bfr* vp = V + ((size_t)((b * NH + h) * L + l)) * VD;
#pragma unroll
  for (int n = 0; n < 64; ++n) vp[n] = f2bf(acc[64 + n]);
}

__global__ __launch_bounds__(256) void k_attn(const bfr* __restrict__ Q, const bfr* __restrict__ K, const bfr* __restrict__ V, const bfr* __restrict__ P2, bfr* __restrict__ AAT) {
  const int bh = blockIdx.y, l = blockIdx.x * 256 + threadIdx.x;
  const float scale = 0.10206207261596575f;
  float q[QKD];
  const bfr* qp = Q + ((size_t)(bh * L + l)) * QKD;
#pragma unroll
  for (int n = 0; n < QKD; ++n) q[n] = bf2f(qp[n]) * scale;
  float o[VD];
#pragma unroll
  for (int d = 0; d < VD; ++d) o[d] = 0.f;
  float m = -1e30f, lsum = 0.f;
  for (int j = 0; j < L; ++j) {
    const bfr* kp = K + ((size_t)(bh * L + j)) * KPAD;
    const bfr* vp = V + ((size_t)(bh * L + j)) * VD;
    float s = 0.f;
#pragma unroll
    for (int n = 0; n < QKD; ++n) s += q[n] * bf2f(kp[n]);
    if (s > m) {
      float a = __expf(m - s); lsum *= a;
#pragma unroll
      for (int d = 0; d < VD; ++d) o[d] *= a;
      m = s;
    }
    float p = __expf(s - m); lsum += p;
#pragma unroll
    for (int d = 0; d < VD; ++d) o[d] += p * bf2f(vp[d]);
  }
  const int b = bh >> 3, h = bh & 7; const size_t tok = (size_t)b * L + l;
  const float inv = 1.f / lsum;
  const bfr* za = P2 + tok * P2W + P2_ZA + h * VD;
  bfr* op = AAT + tok * HY + h * VD;
#pragma unroll
  for (int d = 0; d < VD; ++d) op[d] = f2bf(o[d] * inv * siluf_(bf2f(za[d])));
}

__device__ __forceinline__ float sconv(const bfr* __restrict__ seq, int t, float w0, float w1, float w2, float bb) {
  float a = (t > 0) ? bf2f(seq[t - 1]) : 0.f, c = bf2f(seq[t]), d = (t < L - 1) ? bf2f(seq[t + 1]) : 0.f;
  return w0 * a + w1 * c + w2 * d + bb;
}
template <int O>
__global__ __launch_bounds__(256) void k_hyconv(const bfr* __restrict__ HYT, const float* __restrict__ KF, const float* __restrict__ w_short, const float* __restrict__ b_short,
                                                const float* __restrict__ hy_bias, float* __restrict__ Z2, bfr* __restrict__ AHY) {
  __shared__ float u[L];
  __shared__ float kf[2 * L];
  const int c = blockIdx.y, b = blockIdx.z, tid = threadIdx.x;
  const bfr* sv = HYT + ((size_t)(b * 2048 + c)) * L;
  const bfr* sx = HYT + ((size_t)(b * 2048 + (O == 0 ? 512 : 1024) + c)) * L;
  const int chg = (O == 0 ? 512 : 1024) + c;
  for (int i = tid; i < L; i += 256) {
    if (O == 0) u[i] = sconv(sv, i, w_short[c], w_short[1536 + c], w_short[3072 + c], b_short[c]);
    else u[i] = Z2[((size_t)(b * HY + c)) * L + i];
  }
  const float* kfp = KF + ((size_t)(O * 512 + c)) * 2 * L;
  for (int i = tid; i < 2 * L; i += 256) kf[i] = kfp[i];
  __syncthreads();
  const float bias = hy_bias[O * HY + c];
  for (int t = blockIdx.x * 1024 + tid; t < blockIdx.x * 1024 + 1024; t += 256) {
    float acc = 0.f;
    for (int s = 0; s <= t; ++s) acc += u[s] * kf[t - s];
    for (int s = t + 1; s < L; ++s) acc += u[s] * kf[L + (s - t - 1)];
    float y = acc + bias * u[t];
    float g = sconv(sx, t, w_short[chg], w_short[1536 + chg], w_short[3072 + chg], b_short[chg]);
    if (O == 0) Z2[((size_t)(b * HY + c)) * L + t] = g * y;
    else {
      float zh = bf2f(HYT[((size_t)(b * 2048 + 1536 + c)) * L + t]);
      AHY[((size_t)(b * L + t)) * HY + c] = f2bf(g * y * siluf_(zh));
    }
  }
}

__global__ __launch_bounds__(256) void k_out1(const bfr* __restrict__ AHY, const bfr* __restrict__ AAT, const bfr* __restrict__ WHY, const bfr* __restrict__ WAT,
                                              const bfr* __restrict__ GATES, bfr* __restrict__ MRG) {
  const int wid = threadIdx.x >> 6, lane = threadIdx.x & 63, r16 = lane & 15, quad = lane >> 4;
  const int m0 = blockIdx.y * 64 + (wid >> 1) * 32, n0 = blockIdx.x * 64 + (wid & 1) * 32;
  f32x4 a1[2][2] = {}, a2[2][2] = {};
  gemm_wave_acc(AHY, HY, WHY, HY, HY, m0, n0, a1);
  gemm_wave_acc(AAT, HY, WAT, HY, HY, m0, n0, a2);
  for (int i = 0; i < 2; ++i) for (int j = 0; j < 2; ++j) for (int e = 0; e < 4; ++e) {
    int row = m0 + i * 16 + quad * 4 + e, col = n0 + j * 16 + r16;
    float gh = bf2f(GATES[(size_t)row * 2048 + col]), ga = bf2f(GATES[(size_t)row * 2048 + 1024 + col]);
    MRG[(size_t)row * DM + col] = f2bf(gh * a1[i][j][e] + ga * a2[i][j][e]);
  }
}
__global__ __launch_bounds__(256) void k_out2(const bfr* __restrict__ MRG, const bfr* __restrict__ WOUT, const float* __restrict__ x, float* __restrict__ out) {
  const int wid = threadIdx.x >> 6, lane = threadIdx.x & 63, r16 = lane & 15, quad = lane >> 4;
  const int m0 = blockIdx.y * 64 + (wid >> 1) * 32, n0 = blockIdx.x * 64 + (wid & 1) * 32;
  f32x4 acc[2][2] = {};
  gemm_wave_acc(MRG, DM, WOUT, DM, DM, m0, n0, acc);
  for (int i = 0; i < 2; ++i) for (int j = 0; j < 2; ++j) for (int e = 0; e < 4; ++e) {
    int row = m0 + i * 16 + quad * 4 + e, col = n0 + j * 16 + r16;
    out[(size_t)row * DM + col] = x[(size_t)row * DM + col] + acc[i][j][e];
  }
}

extern "C" void kernel_launch(void* const* d_in, const int* in_sizes, int n_in, void* d_out, int out_size, void* d_ws, size_t ws_size, hipStream_t stream) {
  if (ws_size < WS_END) { fprintf(stderr, "kernel_launch: ws too small: %zu < %zu\n", ws_size, WS_END); return; }
  const float* x = (const float*)d_in[0];      const float* g_norm = (const float*)d_in[1];  const float* w_in = (const float*)d_in[2];
  const float* b_gate = (const float*)d_in[3]; const float* w_short = (const float*)d_in[4]; const float* b_short = (const float*)d_in[5];
  const float* w_f1 = (const float*)d_in[6];   const float* b_f1 = (const float*)d_in[7];    const float* freq1 = (const float*)d_in[8];
  const float* w_f2 = (const float*)d_in[9];   const float* b_f2 = (const float*)d_in[10];   const float* freq2 = (const float*)d_in[11];
  const float* w_f3 = (const float*)d_in[12];  const float* hy_bias = (const float*)d_in[13]; const float* w_hy_out = (const float*)d_in[14];
  const float* g_cq = (const float*)d_in[15];  const float* w_uq = (const float*)d_in[16];   const float* g_ckv = (const float*)d_in[17];
  const float* w_ukv = (const float*)d_in[18]; const float* g_qn = (const float*)d_in[19];   const float* g_kn = (const float*)d_in[20];
  const float* w_attn_out = (const float*)d_in[21]; const float* w_out = (const float*)d_in[22];
  char* ws = (char*)d_ws;
  float* RSTD = (float*)(ws + OFF_RSTD); float* ROPE = (float*)(ws + OFF_ROPE); float* H2 = (float*)(ws + OFF_H2);
  bfr* WIN = (bfr*)(ws + OFF_WIN); bfr* WHY = (bfr*)(ws + OFF_WHY); bfr* WAT = (bfr*)(ws + OFF_WAT); bfr* WOUT = (bfr*)(ws + OFF_WOUT);
  bfr* HYT = (bfr*)(ws + OFF_HYT); bfr* P2 = (bfr*)(ws + OFF_P2); bfr* Q = (bfr*)(ws + OFF_Q); bfr* K = (bfr*)(ws + OFF_K); bfr* V = (bfr*)(ws + OFF_V);
  float* KF = (float*)(ws + OFF_KF); bfr* AHY = (bfr*)(ws + OFF_AHY); bfr* AAT = (bfr*)(ws + OFF_AAT);
  bfr* XB = (bfr*)(ws + OFF_XB); float* Z2 = (float*)(ws + OFF_Z2); bfr* MRG = (bfr*)(ws + OFF_MRG);
  bfr* GATES = (bfr*)d_out; float* out = (float*)d_out;

  k_rope<<<L * 16 / 256, 256, 0, stream>>>(ROPE);
  k_filt_h<<<L, 64, 0, stream>>>(w_f1, b_f1, freq1, w_f2, b_f2, freq2, H2);
  k_filt_k<<<dim3(L / 256, 2048), 256, 0, stream>>>(H2, w_f3, KF);
  k_wT<<<dim3(INCP / 256, DM), 256, 0, stream>>>(w_in, g_norm, WIN, DM, INC, INCP);
  k_wT<<<dim3(DM / 256, HY), 256, 0, stream>>>(w_hy_out, nullptr, WHY, HY, DM, DM);
  k_wT<<<dim3(DM / 256, HY), 256, 0, stream>>>(w_attn_out, nullptr, WAT, HY, DM, DM);
  k_wT<<<dim3(DM / 256, DM), 256, 0, stream>>>(w_out, nullptr, WOUT, DM, DM, DM);
  k_rstd_xb<<<NTOK / 4, 256, 0, stream>>>(x, XB, RSTD);
  k_inproj<<<dim3(INCP / 64, NTOK / 64), 256, 0, stream>>>(XB, WIN, RSTD, b_gate, HYT, P2, GATES);
  k_q<<<dim3(NTOK / 256, NH), 256, 0, stream>>>(P2, g_cq, w_uq, g_qn, ROPE, Q);
  k_kv<<<dim3(NTOK / 256, NH), 256, 0, stream>>>(P2, g_ckv, w_ukv, g_kn, ROPE, K, V);
  k_attn<<<dim3(L / 256, NB * NH), 256, 0, stream>>>(Q, K, V, P2, AAT);
  k_hyconv<0><<<dim3(L / 1024, HY, NB), 256, 0, stream>>>(HYT, KF, w_short, b_short, hy_bias, Z2, AHY);
  k_hyconv<1><<<dim3(L / 1024, HY, NB), 256, 0, stream>>>(HYT, KF, w_short, b_short, hy_bias, Z2, AHY);
  k_out1<<<dim3(DM / 64, NTOK / 64), 256, 0, stream>>>(AHY, AAT, WHY, WAT, GATES, MRG);
  k_out2<<<dim3(DM / 64, NTOK / 64), 256, 0, stream>>>(MRG, WOUT, x, out);
}
```

```cpp
#include <hip/hip_runtime.h>
#include <hip/hip_cooperative_groups.h>
#include <cstdio>
#include <cstdint>

typedef unsigned short bfr;
using bf16x8 = __attribute__((ext_vector_type(8))) short;
using f32x4  = __attribute__((ext_vector_type(4))) float;

constexpr int NB = 8, L = 4096, DM = 1024, NTOK = NB * L;
constexpr int HY = 512, INC = 5280, INCP = 5376;
constexpr int P2W = 1184;
constexpr int P2_CQ = 0, P2_CKV = 384, P2_KR = 640, P2_ZA = 672;
constexpr int NH = 8, QKD = 96, KPAD = 128, VD = 64, QL = 384, KVL = 256;
constexpr float EPS = 1e-6f;
constexpr float PI_F = 3.14159265358979323846f;

constexpr size_t al256(size_t x) { return (x + 255) / 256 * 256; }
constexpr size_t OFF_RSTD = 0;
constexpr size_t OFF_ROPE = OFF_RSTD + al256((size_t)NTOK * 4);
constexpr size_t OFF_H2   = OFF_ROPE + al256((size_t)L * 32 * 4);
constexpr size_t OFF_WIN  = OFF_H2 + al256((size_t)L * 64 * 4);
constexpr size_t OFF_WHY  = OFF_WIN + al256((size_t)INCP * DM * 2);
constexpr size_t OFF_WAT  = OFF_WHY + al256((size_t)DM * HY * 2);
constexpr size_t OFF_WOUT = OFF_WAT + al256((size_t)DM * HY * 2);
constexpr size_t OFF_HYT  = OFF_WOUT + al256((size_t)DM * DM * 2);
constexpr size_t OFF_P2   = OFF_HYT + al256((size_t)NB * 2048 * L * 2);
constexpr size_t OFF_Q    = OFF_P2 + al256((size_t)NTOK * P2W * 2);
constexpr size_t OFF_K    = OFF_Q + al256((size_t)NTOK * NH * QKD * 2);
constexpr size_t OFF_V    = OFF_K + al256((size_t)NTOK * NH * KPAD * 2);
constexpr size_t OFF_KF   = OFF_V + al256((size_t)NTOK * NH * VD * 2);
constexpr size_t OFF_AHY  = OFF_KF + al256((size_t)2 * HY * 2 * L * 4);
constexpr size_t OFF_AAT  = OFF_AHY + al256((size_t)NTOK * HY * 2);
constexpr size_t WS_END   = OFF_AAT + al256((size_t)NTOK * HY * 2);
constexpr size_t OFF_XB   = OFF_Q;
constexpr size_t OFF_Z2   = OFF_Q;
constexpr size_t OFF_MRG  = OFF_HYT;

__device__ __forceinline__ bfr f2bf(float x) { unsigned u = __float_as_uint(x); u += 0x7fffu + ((u >> 16) & 1u); return (bfr)(u >> 16); }
__device__ __forceinline__ float bf2f(bfr h) { return __uint_as_float(((unsigned)h) << 16); }
__device__ __forceinline__ float sigmoidf_(float x) { return 1.f / (1.f + __expf(-x)); }
__device__ __forceinline__ float siluf_(float x) { return x / (1.f + __expf(-x)); }


namespace cg = cooperative_groups;
constexpr int NT = 512;
constexpr size_t LDS_BYTES = 65536;

struct Params {
  const float *x, *g_norm, *w_in, *b_gate, *w_short, *b_short, *w_f1, *b_f1, *freq1, *w_f2, *b_f2, *freq2, *w_f3, *hy_bias, *w_hy_out,
              *g_cq, *w_uq, *g_ckv, *w_ukv, *g_qn, *g_kn, *w_attn_out, *w_out;
  float* out; char* ws;
};

__device__ void wT_phase(const float* __restrict__ src, const float* __restrict__ scale, bfr* __restrict__ dst, int K, int N, int NP) {
  const size_t total = (size_t)K * NP;
  for (size_t i = (size_t)blockIdx.x * NT + threadIdx.x; i < total; i += (size_t)gridDim.x * NT) {
    int k = (int)(i / NP), n = (int)(i % NP);
    float v = 0.f;
    if (n < N) { v = src[(size_t)k * N + n]; if (scale) v *= scale[k]; }
    dst[(size_t)n * K + k] = f2bf(v);
  }
}

__device__ void phase0(const Params& p, char* smem) {
  char* ws = p.ws;
  float* ROPE = (float*)(ws + OFF_ROPE); float* H2 = (float*)(ws + OFF_H2); float* RSTD = (float*)(ws + OFF_RSTD);
  bfr* XB = (bfr*)(ws + OFF_XB);
  const int tid = threadIdx.x, wid = tid >> 6, lane = tid & 63;
  for (int idx = blockIdx.x * NT + tid; idx < L * 16; idx += gridDim.x * NT) {
    int l = idx >> 4, j = idx & 15;
    float inv = powf(10000.f, -(float)(2 * j) / 32.f);
    float ang = (float)l * inv;
    ROPE[idx * 2] = cosf(ang); ROPE[idx * 2 + 1] = sinf(ang);
  }
  wT_phase(p.w_in, p.g_norm, (bfr*)(ws + OFF_WIN), DM, INC, INCP);
  wT_phase(p.w_hy_out, nullptr, (bfr*)(ws + OFF_WHY), HY, DM, DM);
  wT_phase(p.w_attn_out, nullptr, (bfr*)(ws + OFF_WAT), HY, DM, DM);
  wT_phase(p.w_out, nullptr, (bfr*)(ws + OFF_WOUT), DM, DM, DM);
  {
    float* z = (float*)smem + wid * 128; float* h1 = z + 64;
    for (int it = blockIdx.x; it < L / 8; it += gridDim.x) {
      const int t = it * 8 + wid, j = lane;
      if (j < 33) {
        float v;
        if (j == 0) v = (float)t / (float)(L - 1);
        else { int i = (j - 1) & 15; float f = 1e-4f + (float)i * ((15.f - 1e-4f) / 15.f); float ang = ((2.f * PI_F / (float)L) * (float)t) * f;
               v = (j <= 16) ? cosf(ang) : -sinf(ang); }
        z[j] = v;
      }
      __syncthreads();
      float a = p.b_f1[j];
      for (int i = 0; i < 33; ++i) a += z[i] * p.w_f1[i * 64 + j];
      h1[j] = sinf(p.freq1[j] * a);
      __syncthreads();
      float c = p.b_f2[j];
      for (int i = 0; i < 64; ++i) c += h1[i] * p.w_f2[i * 64 + j];
      H2[t * 64 + j] = sinf(p.freq2[j] * c);
      __syncthreads();
    }
  }
  for (int row = blockIdx.x * 8 + wid; row < NTOK; row += gridDim.x * 8) {
    const float4* px = (const float4*)(p.x + (size_t)row * DM);
    float ss = 0.f;
    for (int i = 0; i < 4; ++i) {
      float4 v = px[lane + 64 * i];
      ss += v.x * v.x + v.y * v.y + v.z * v.z + v.w * v.w;
      ushort4 o; o.x = f2bf(v.x); o.y = f2bf(v.y); o.z = f2bf(v.z); o.w = f2bf(v.w);
      ((ushort4*)(XB + (size_t)row * DM))[lane + 64 * i] = o;
    }
    for (int off = 32; off > 0; off >>= 1) ss += __shfl_xor(ss, off);
    if (lane == 0) RSTD[row] = rsqrtf(ss / (float)DM + EPS);
  }
}

__device__ void phase_filt_k(const Params& p) {
  const float* H2 = (const float*)(p.ws + OFF_H2); float* KF = (float*)(p.ws + OFF_KF);
  for (int idx = blockIdx.x * NT + threadIdx.x; idx < 2048 * L; idx += gridDim.x * NT) {
    const int t = idx & (L - 1), col = idx >> 12;
    const int o = col >> 10, dir = (col >> 9) & 1, c = col & 511;
    float acc = 0.f;
    for (int j = 0; j < 64; ++j) acc += H2[t * 64 + j] * p.w_f3[j * 2048 + col];
    const float MIN_DECAY = -3.0701134573253944f, MAX_DECAY = -15.350567286626972f;
    float delta = fabsf(MIN_DECAY + (MAX_DECAY - MIN_DECAY) * ((float)c / 511.f));
    float tl = (float)t / (float)(L - 1);
    KF[((size_t)((o * 512 + c) * 2 + dir)) * L + t] = acc * expf(-tl * delta);
  }
}

__device__ __forceinline__ void gemm_wave_acc(const bfr* __restrict__ A, int lda, const bfr* __restrict__ Bt, int ldb, int K, int m0, int n0, f32x4 (&acc)[2][2]) {
  const int lane = threadIdx.x & 63, r16 = lane & 15, quad = lane >> 4;
  for (int k0 = 0; k0 < K; k0 += 32) {
    bf16x8 a[2], b[2];
    for (int i = 0; i < 2; ++i) a[i] = *(const bf16x8*)(A + (size_t)(m0 + i * 16 + r16) * lda + k0 + quad * 8);
    for (int j = 0; j < 2; ++j) b[j] = *(const bf16x8*)(Bt + (size_t)(n0 + j * 16 + r16) * ldb + k0 + quad * 8);
    for (int i = 0; i < 2; ++i) for (int j = 0; j < 2; ++j) acc[i][j] = __builtin_amdgcn_mfma_f32_16x16x32_bf16(a[i], b[j], acc[i][j], 0, 0, 0);
  }
}

__device__ void phase_inproj(const Params& p) {
  char* ws = p.ws;
  const bfr* XB = (const bfr*)(ws + OFF_XB); const bfr* WIN = (const bfr*)(ws + OFF_WIN); const float* rstd = (const float*)(ws + OFF_RSTD);
  bfr* HYT = (bfr*)(ws + OFF_HYT); bfr* P2 = (bfr*)(ws + OFF_P2); bfr* GATES = (bfr*)p.out;
  const int wid = threadIdx.x >> 6, lane = threadIdx.x & 63, r16 = lane & 15, quad = lane >> 4;
  constexpr int NTN = INCP / 128, NTM = NTOK / 64;
  for (int it = blockIdx.x; it < NTN * NTM; it += gridDim.x) {
    const int tn = it % NTN, tm = it / NTN;
    const int m0 = tm * 64 + (wid >> 2) * 32, n0 = tn * 128 + (wid & 3) * 32;
    f32x4 acc[2][2] = {};
    gemm_wave_acc(XB, DM, WIN, DM, DM, m0, n0, acc);
    for (int i = 0; i < 2; ++i) for (int j = 0; j < 2; ++j) for (int e = 0; e < 4; ++e) {
      int row = m0 + i * 16 + quad * 4 + e, col = n0 + j * 16 + r16;
      float v = acc[i][j][e] * rstd[row];
      if (col < 2048) { int b = row >> 12, l = row & 4095; HYT[((size_t)(b * 2048 + col)) * L + l] = f2bf(v); }
      else if (col < 3232) P2[(size_t)row * P2W + (col - 2048)] = f2bf(v);
      else if (col < INC) GATES[(size_t)row * 2048 + (col - 3232)] = f2bf(sigmoidf_(v + p.b_gate[col - 3232]));
    }
  }
}

__device__ void phase_qkv(const Params& p) {
  char* ws = p.ws;
  const bfr* P2 = (const bfr*)(ws + OFF_P2); const float* rope = (const float*)(ws + OFF_ROPE);
  bfr* Q = (bfr*)(ws + OFF_Q); bfr* K = (bfr*)(ws + OFF_K); bfr* V = (bfr*)(ws + OFF_V);
  constexpr int NIT = (NTOK / NT) * NH;
  for (int it = blockIdx.x; it < 2 * NIT; it += gridDim.x) {
    const int which = it / NIT, r = it % NIT, h = r % NH, tok = (r / NH) * NT + threadIdx.x;
    const int b = tok >> 12, l = tok & 4095;
    if (which == 0) {
      const bfr* pp = P2 + (size_t)tok * P2W + P2_CQ;
      float ss = 0.f;
      for (int k = 0; k < QL; ++k) { float a = bf2f(pp[k]); ss += a * a; }
      const float rs = rsqrtf(ss / (float)QL + EPS);
      float acc[QKD];
#pragma unroll
      for (int n = 0; n < QKD; ++n) acc[n] = 0.f;
      for (int k = 0; k < QL; ++k) {
        const float a = bf2f(pp[k]) * rs * p.g_cq[k];
        const float* w = p.w_uq + (size_t)k * (NH * QKD) + h * QKD;
#pragma unroll
        for (int n = 0; n < QKD; ++n) acc[n] += a * w[n];
      }
      float s2 = 0.f;
#pragma unroll
      for (int n = 0; n < QKD; ++n) s2 += acc[n] * acc[n];
      const float r2 = rsqrtf(s2 / (float)QKD + EPS);
#pragma unroll
      for (int n = 0; n < QKD; ++n) acc[n] *= r2 * p.g_qn[n];
#pragma unroll
      for (int i = 0; i < 16; ++i) {
        float c = rope[(l * 16 + i) * 2], s = rope[(l * 16 + i) * 2 + 1];
        float t1 = acc[64 + i], t2 = acc[80 + i];
        acc[64 + i] = t1 * c - t2 * s; acc[80 + i] = t1 * s + t2 * c;
      }
      bfr* q = Q + ((size_t)((b * NH + h) * L + l)) * QKD;
#pragma unroll
      for (int n = 0; n < QKD; ++n) q[n] = f2bf(acc[n]);
    } else {
      const bfr* pp = P2 + (size_t)tok * P2W + P2_CKV;
      float ss = 0.f;
      for (int k = 0; k < KVL; ++k) { float a = bf2f(pp[k]); ss += a * a; }
      const float rs = rsqrtf(ss / (float)KVL + EPS);
      float acc[128];
#pragma unroll
      for (int n = 0; n < 128; ++n) acc[n] = 0.f;
      for (int k = 0; k < KVL; ++k) {
        const float a = bf2f(pp[k]) * rs * p.g_ckv[k];
        const float* w = p.w_ukv + (size_t)k * (NH * 128) + h * 128;
#pragma unroll
        for (int n = 0; n < 128; ++n) acc[n] += a * w[n];
      }
      const bfr* kr = P2 + (size_t)tok * P2W + P2_KR;
      float s2 = 0.f;
#pragma unroll
      for (int n = 0; n < 64; ++n) s2 += acc[n] * acc[n];
      for (int i = 0; i < 32; ++i) { float a = bf2f(kr[i]); s2 += a * a; }
      const float r2 = rsqrtf(s2 / (float)QKD + EPS);
      bfr* kp = K + ((size_t)((b * NH + h) * L + l)) * KPAD;
#pragma unroll
      for (int n = 0; n < 64; ++n) kp[n] = f2bf(acc[n] * r2 * p.g_kn[n]);
      for (int i = 0; i < 16; ++i) {
        float c = rope[(l * 16 + i) * 2], s = rope[(l * 16 + i) * 2 + 1];
        float t1 = bf2f(kr[i]) * r2 * p.g_kn[64 + i], t2 = bf2f(kr[16 + i]) * r2 * p.g_kn[80 + i];
        kp[64 + i] = f2bf(t1 * c - t2 * s); kp[80 + i] = f2bf(t1 * s + t2 * c);
      }
      for (int n = 96; n < 128; ++n) kp[n] = 0;
      bfr* vp = V + ((size_t)((b * NH + h) * L + l)) * VD;
#pragma unroll
      for (int n = 0; n < 64; ++n) vp[n] = f2bf(acc[64 + n]);
    }
  }
}

__device__ void phase_attn(const Params& p) {
  char* ws = p.ws;
  const bfr* Q = (const bfr*)(ws + OFF_Q); const bfr* K = (const bfr*)(ws + OFF_K); const bfr* V = (const bfr*)(ws + OFF_V);
  const bfr* P2 = (const bfr*)(ws + OFF_P2); bfr* AAT = (bfr*)(ws + OFF_AAT);
  constexpr int NIT = (L / NT) * NB * NH;
  for (int it = blockIdx.x; it < NIT; it += gridDim.x) {
    const int bh = it / (L / NT), l = (it % (L / NT)) * NT + threadIdx.x;
    const float scale = 0.10206207261596575f;
    float q[QKD];
    const bfr* qp = Q + ((size_t)(bh * L + l)) * QKD;
#pragma unroll
    for (int n = 0; n < QKD; ++n) q[n] = bf2f(qp[n]) * scale;
    float o[VD];
#pragma unroll
    for (int d = 0; d < VD; ++d) o[d] = 0.f;
    float m = -1e30f, lsum = 0.f;
    for (int j = 0; j < L; ++j) {
      const bfr* kp = K + ((size_t)(bh * L + j)) * KPAD;
      const bfr* vp = V + ((size_t)(bh * L + j)) * VD;
      float s = 0.f;
#pragma unroll
      for (int n = 0; n < QKD; ++n) s += q[n] * bf2f(kp[n]);
      if (s > m) {
        float a = __expf(m - s); lsum *= a;
#pragma unroll
        for (int d = 0; d < VD; ++d) o[d] *= a;
        m = s;
      }
      float pe = __expf(s - m); lsum += pe;
#pragma unroll
      for (int d = 0; d < VD; ++d) o[d] += pe * bf2f(vp[d]);
    }
    const int b = bh >> 3, h = bh & 7; const size_t tok = (size_t)b * L + l;
    const float inv = 1.f / lsum;
    const bfr* za = P2 + tok * P2W + P2_ZA + h * VD;
    bfr* op = AAT + tok * HY + h * VD;
#pragma unroll
    for (int d = 0; d < VD; ++d) op[d] = f2bf(o[d] * inv * siluf_(bf2f(za[d])));
  }
}

__device__ __forceinline__ float sconv(const bfr* __restrict__ seq, int t, float w0, float w1, float w2, float bb) {
  float a = (t > 0) ? bf2f(seq[t - 1]) : 0.f, c = bf2f(seq[t]), d = (t < L - 1) ? bf2f(seq[t + 1]) : 0.f;
  return w0 * a + w1 * c + w2 * d + bb;
}
__device__ void phase_hyena(const Params& p, char* smem) {
  char* ws = p.ws;
  const bfr* HYT = (const bfr*)(ws + OFF_HYT); const float* KF = (const float*)(ws + OFF_KF); bfr* AHY = (bfr*)(ws + OFF_AHY);
  float* u = (float*)smem; float* z2 = u + L; float* kf = z2 + L;
  const int tid = threadIdx.x;
  for (int it = blockIdx.x; it < NB * HY; it += gridDim.x) {
    const int b = it / HY, c = it % HY;
    const bfr* sv = HYT + ((size_t)(b * 2048 + c)) * L;
    __syncthreads();
    for (int i = tid; i < L; i += NT) u[i] = sconv(sv, i, p.w_short[c], p.w_short[1536 + c], p.w_short[3072 + c], p.b_short[c]);
    for (int o = 0; o < 2; ++o) {
      const float* kfp = KF + ((size_t)(o * 512 + c)) * 2 * L;
      __syncthreads();
      for (int i = tid; i < 2 * L; i += NT) kf[i] = kfp[i];
      __syncthreads();
      const float* src = o == 0 ? u : z2;
      const int chg = (o == 0 ? 512 : 1024) + c;
      const bfr* sx = HYT + ((size_t)(b * 2048 + chg)) * L;
      const float bias = p.hy_bias[o * HY + c];
      for (int t = tid; t < L; t += NT) {
        float acc = 0.f;
        for (int s = 0; s <= t; ++s) acc += src[s] * kf[t - s];
        for (int s = t + 1; s < L; ++s) acc += src[s] * kf[L + (s - t - 1)];
        float y = acc + bias * src[t];
        float g = sconv(sx, t, p.w_short[chg], p.w_short[1536 + chg], p.w_short[3072 + chg], p.b_short[chg]);
        if (o == 0) z2[t] = g * y;
        else {
          float zh = bf2f(HYT[((size_t)(b * 2048 + 1536 + c)) * L + t]);
          AHY[((size_t)(b * L + t)) * HY + c] = f2bf(g * y * siluf_(zh));
        }
      }
    }
  }
}

__device__ void phase_out1(const Params& p) {
  char* ws = p.ws;
  const bfr* AHY = (const bfr*)(ws + OFF_AHY); const bfr* AAT = (const bfr*)(ws + OFF_AAT); const bfr* WHY = (const bfr*)(ws + OFF_WHY); const bfr* WAT = (const bfr*)(ws + OFF_WAT);
  const bfr* GATES = (const bfr*)p.out; bfr* MRG = (bfr*)(ws + OFF_MRG);
  const int wid = threadIdx.x >> 6, lane = threadIdx.x & 63, r16 = lane & 15, quad = lane >> 4;
  constexpr int NTN = DM / 128, NTM = NTOK / 64;
  for (int it = blockIdx.x; it < NTN * NTM; it += gridDim.x) {
    const int tn = it % NTN, tm = it / NTN;
    const int m0 = tm * 64 + (wid >> 2) * 32, n0 = tn * 128 + (wid & 3) * 32;
    f32x4 a1[2][2] = {}, a2[2][2] = {};
    gemm_wave_acc(AHY, HY, WHY, HY, HY, m0, n0, a1);
    gemm_wave_acc(AAT, HY, WAT, HY, HY, m0, n0, a2);
    for (int i = 0; i < 2; ++i) for (int j = 0; j < 2; ++j) for (int e = 0; e < 4; ++e) {
      int row = m0 + i * 16 + quad * 4 + e, col = n0 + j * 16 + r16;
      float gh = bf2f(GATES[(size_t)row * 2048 + col]), ga = bf2f(GATES[(size_t)row * 2048 + 1024 + col]);
      MRG[(size_t)row * DM + col] = f2bf(gh * a1[i][j][e] + ga * a2[i][j][e]);
    }
  }
}
__device__ void phase_out2(const Params& p) {
  char* ws = p.ws;
  const bfr* MRG = (const bfr*)(ws + OFF_MRG); const bfr* WOUT = (const bfr*)(ws + OFF_WOUT);
  const int wid = threadIdx.x >> 6, lane = threadIdx.x & 63, r16 = lane & 15, quad = lane >> 4;
  constexpr int NTN = DM / 128, NTM = NTOK / 64;
  for (int it = blockIdx.x; it < NTN * NTM; it += gridDim.x) {
    const int tn = it % NTN, tm = it / NTN;
    const int m0 = tm * 64 + (wid >> 2) * 32, n0 = tn * 128 + (wid & 3) * 32;
    f32x4 acc[2][2] = {};
    gemm_wave_acc(MRG, DM, WOUT, DM, DM, m0, n0, acc);
    for (int i = 0; i < 2; ++i) for (int j = 0; j < 2; ++j) for (int e = 0; e < 4; ++e) {
      int row = m0 + i * 16 + quad * 4 + e, col = n0 + j * 16 + r16;
      p.out[(size_t)row * DM + col] = p.x[(size_t)row * DM + col] + acc[i][j][e];
    }
  }
}

__global__ __launch_bounds__(NT, 1) void fwd_megakernel(Params p) {
  extern __shared__ __attribute__((aligned(16))) char smem[];
  cg::grid_group grid = cg::this_grid();
  phase0(p, smem);
  grid.sync();
  phase_filt_k(p);
  phase_inproj(p);
  grid.sync();
  phase_qkv(p);
  grid.sync();
  phase_attn(p);
  phase_hyena(p, smem);
  grid.sync();
  phase_out1(p);
  grid.sync();
  phase_out2(p);
}

extern "C" void kernel_launch(void* const* d_in, const int* in_sizes, int n_in, void* d_out, int out_size, void* d_ws, size_t ws_size, hipStream_t stream) {
  if (ws_size < WS_END) { fprintf(stderr, "kernel_launch: ws too small: %zu < %zu\n", ws_size, WS_END); return; }
  static int grid_blocks = 0;
  if (!grid_blocks) {
    int dev = 0, cus = 0, per_cu = 0;
    hipGetDevice(&dev);
    hipDeviceGetAttribute(&cus, hipDeviceAttributeMultiprocessorCount, dev);
    hipFuncSetAttribute((const void*)fwd_megakernel, hipFuncAttributeMaxDynamicSharedMemorySize, (int)LDS_BYTES);
    hipOccupancyMaxActiveBlocksPerMultiprocessor(&per_cu, fwd_megakernel, NT, LDS_BYTES);
    if (per_cu < 1) { fprintf(stderr, "kernel_launch: occupancy query returned %d\n", per_cu); return; }
    if (per_cu > 1) per_cu = 1;
    grid_blocks = cus * per_cu;
  }
  Params p{};
  const float** f = (const float**)&p;
  for (int i = 0; i < 23; ++i) f[i] = (const float*)d_in[i];
  p.out = (float*)d_out; p.ws = (char*)d_ws;
  void* args[] = {&p};
  hipError_t e = hipLaunchCooperativeKernel((void*)fwd_megakernel, dim3(grid_blocks), dim3(NT), args, LDS_BYTES, stream);
  if (e != hipSuccess) fprintf(stderr, "cooperative launch failed: %s (grid %d)\n", hipGetErrorString(e), grid_blocks);
}
```

```cpp
#include <hip/hip_runtime.h>
#include <hip/hip_cooperative_groups.h>
#include <cstdio>
#include <cstdint>

typedef unsigned short bfr;
using bf16x8 = __attribute__((ext_vector_type(8))) short;
using f32x4  = __attribute__((ext_vector_type(4))) float;
using s16x4  = __attribute__((ext_vector_type(4))) short;
using f32x16 = __attribute__((ext_vector_type(16))) float;
using u32x4  = __attribute__((ext_vector_type(4))) unsigned;
#define SBAR() __builtin_amdgcn_sched_barrier(0)
__device__ __forceinline__ int otid() { int t = threadIdx.x; asm volatile("" : "+v"(t)); return t; }
__device__ __forceinline__ int crow(int r, int hi) { return (r & 3) + 8 * (r >> 2) + 4 * hi; }
__device__ __forceinline__ unsigned cvtpk(float lo, float hi) { unsigned r; asm volatile("v_cvt_pk_bf16_f32 %0, %1, %2" : "=v"(r) : "v"(lo), "v"(hi)); return r; }

constexpr int NB = 8, L = 4096, DM = 1024, NTOK = NB * L;
constexpr int HY = 512, INC = 5280, INCP = 5376;
constexpr int P2W = 1184;
constexpr int P2_CQ = 0, P2_CKV = 384, P2_KR = 640, P2_ZA = 672;
constexpr int NH = 8, QKD = 96, KPAD = 128, VD = 64, QL = 384, KVL = 256;
constexpr float EPS = 1e-6f;
constexpr float PI_F = 3.14159265358979323846f;

constexpr size_t al256(size_t x) { return (x + 255) / 256 * 256; }
constexpr size_t OFF_RSTD = 0;
constexpr size_t OFF_ROPE = OFF_RSTD + al256((size_t)NTOK * 4);
constexpr size_t OFF_H2   = OFF_ROPE + al256((size_t)L * 32 * 4);
constexpr size_t OFF_WIN  = OFF_H2 + al256((size_t)L * 64 * 4);
constexpr size_t OFF_WHY  = OFF_WIN + al256((size_t)INCP * DM * 2);
constexpr size_t OFF_WAT  = OFF_WHY + al256((size_t)DM * HY * 2);
constexpr size_t OFF_WOUT = OFF_WAT + al256((size_t)DM * HY * 2);
constexpr size_t OFF_HYT  = OFF_WOUT + al256((size_t)DM * DM * 2);
constexpr size_t OFF_P2   = OFF_HYT + al256((size_t)NB * 2048 * L * 2);
constexpr size_t OFF_Q    = OFF_P2 + al256((size_t)NTOK * P2W * 2);
constexpr size_t OFF_K    = OFF_Q + al256((size_t)NTOK * NH * QKD * 2);
constexpr size_t OFF_V    = OFF_K + al256((size_t)NTOK * NH * KPAD * 2);
constexpr size_t OFF_KS   = OFF_V + al256((size_t)NTOK * NH * VD * 2);
constexpr size_t OFF_AHY  = OFF_KS + al256((size_t)2 * HY * 16 * 512 * 8);
constexpr size_t OFF_AAT  = OFF_AHY + al256((size_t)NTOK * HY * 2);
constexpr size_t OFF_TW0  = OFF_AAT + al256((size_t)NTOK * HY * 2);
constexpr size_t OFF_TW1  = OFF_TW0 + al256((size_t)4096 * 8);
constexpr size_t OFF_TW2  = OFF_TW1 + al256((size_t)4096 * 8);
constexpr size_t OFF_WUQ  = OFF_TW2 + al256((size_t)256 * 8);
constexpr size_t OFF_WUKV = OFF_WUQ + al256((size_t)NH * QKD * QL * 2);
constexpr size_t WS_END   = OFF_WUKV + al256((size_t)NH * 128 * KVL * 2);
constexpr size_t OFF_KF   = OFF_AHY;
constexpr size_t OFF_XB   = OFF_Q;
constexpr size_t OFF_MRG  = OFF_HYT;

__device__ __forceinline__ bfr f2bf(float x) { unsigned u = __float_as_uint(x); u += 0x7fffu + ((u >> 16) & 1u); return (bfr)(u >> 16); }
__device__ __forceinline__ float bf2f(bfr h) { return __uint_as_float(((unsigned)h) << 16); }
__device__ __forceinline__ float sigmoidf_(float x) { return 1.f / (1.f + __expf(-x)); }
__device__ __forceinline__ float siluf_(float x) { return x / (1.f + __expf(-x)); }


namespace cg = cooperative_groups;
constexpr int NT = 512;
constexpr int FLD = 16 * 272;
constexpr size_t LDS_BYTES = 131072;

struct Params {
  const float *x, *g_norm, *w_in, *b_gate, *w_short, *b_short, *w_f1, *b_f1, *freq1, *w_f2, *b_f2, *freq2, *w_f3, *hy_bias, *w_hy_out,
              *g_cq, *w_uq, *g_ckv, *w_ukv, *g_qn, *g_kn, *w_attn_out, *w_out;
  float* out; char* ws;
};

__device__ void wT_phase(const float* __restrict__ src, const float* __restrict__ scale, bfr* __restrict__ dst, int K, int N, int NP) {
  const size_t total = (size_t)K * NP;
  for (size_t i = (size_t)blockIdx.x * NT + threadIdx.x; i < total; i += (size_t)gridDim.x * NT) {
    int k = (int)(i / NP), n = (int)(i % NP);
    float v = 0.f;
    if (n < N) { v = src[(size_t)k * N + n]; if (scale) v *= scale[k]; }
    dst[(size_t)n * K + k] = f2bf(v);
  }
}

__device__ void phase0(const Params& p, char* smem) {
  char* ws = p.ws;
  float* ROPE = (float*)(ws + OFF_ROPE); float* H2 = (float*)(ws + OFF_H2); float* RSTD = (float*)(ws + OFF_RSTD);
  bfr* XB = (bfr*)(ws + OFF_XB);
  const int tid = threadIdx.x, wid = tid >> 6, lane = tid & 63;
  for (int idx = blockIdx.x * NT + tid; idx < L * 16; idx += gridDim.x * NT) {
    int l = idx >> 4, j = idx & 15;
    float inv = powf(10000.f, -(float)(2 * j) / 32.f);
    float ang = (float)l * inv;
    ROPE[idx * 2] = cosf(ang); ROPE[idx * 2 + 1] = sinf(ang);
  }
  {
    float2* TW0 = (float2*)(ws + OFF_TW0); float2* TW1 = (float2*)(ws + OFF_TW1); float2* TW2 = (float2*)(ws + OFF_TW2);
    for (int idx = blockIdx.x * NT + tid; idx < 4096 + 4096 + 256; idx += gridDim.x * NT) {
      if (idx < 4096) { float a = (float)idx / 4096.f; TW0[idx] = make_float2(cospif(a), -sinpif(a)); }
      else if (idx < 8192) { int j = idx - 4096; int k1 = j >> 8, m = j & 255; float a = (float)((k1 * m) & 4095) / 2048.f; TW1[j] = make_float2(cospif(a), -sinpif(a)); }
      else { int j = idx - 8192; int k2 = j >> 4, n3 = j & 15; float a = (float)((k2 * n3) & 255) / 128.f; TW2[j] = make_float2(cospif(a), -sinpif(a)); }
    }
  }
  wT_phase(p.w_in, p.g_norm, (bfr*)(ws + OFF_WIN), DM, INC, INCP);
  wT_phase(p.w_hy_out, nullptr, (bfr*)(ws + OFF_WHY), HY, DM, DM);
  wT_phase(p.w_attn_out, nullptr, (bfr*)(ws + OFF_WAT), HY, DM, DM);
  wT_phase(p.w_out, nullptr, (bfr*)(ws + OFF_WOUT), DM, DM, DM);
  wT_phase(p.w_uq, p.g_cq, (bfr*)(ws + OFF_WUQ), QL, NH * QKD, NH * QKD);
  wT_phase(p.w_ukv, p.g_ckv, (bfr*)(ws + OFF_WUKV), KVL, NH * 128, NH * 128);
  {
    float* z = (float*)smem + wid * 128; float* h1 = z + 64;
    for (int it = blockIdx.x; it < L / 8; it += gridDim.x) {
      const int t = it * 8 + wid, j = lane;
      if (j < 33) {
        float v;
        if (j == 0) v = (float)t / (float)(L - 1);
        else { int i = (j - 1) & 15; float f = 1e-4f + (float)i * ((15.f - 1e-4f) / 15.f); float ang = ((2.f * PI_F / (float)L) * (float)t) * f;
               v = (j <= 16) ? cosf(ang) : -sinf(ang); }
        z[j] = v;
      }
      __syncthreads();
      float a = p.b_f1[j];
      for (int i = 0; i < 33; ++i) a += z[i] * p.w_f1[i * 64 + j];
      h1[j] = sinf(p.freq1[j] * a);
      __syncthreads();
      float c = p.b_f2[j];
      for (int i = 0; i < 64; ++i) c += h1[i] * p.w_f2[i * 64 + j];
      H2[t * 64 + j] = sinf(p.freq2[j] * c);
      __syncthreads();
    }
  }
  for (int row = blockIdx.x * 8 + wid; row < NTOK; row += gridDim.x * 8) {
    const float4* px = (const float4*)(p.x + (size_t)row * DM);
    float ss = 0.f;
    for (int i = 0; i < 4; ++i) {
      float4 v = px[lane + 64 * i];
      ss += v.x * v.x + v.y * v.y + v.z * v.z + v.w * v.w;
      ushort4 o; o.x = f2bf(v.x); o.y = f2bf(v.y); o.z = f2bf(v.z); o.w = f2bf(v.w);
      ((ushort4*)(XB + (size_t)row * DM))[lane + 64 * i] = o;
    }
    for (int off = 32; off > 0; off >>= 1) ss += __shfl_xor(ss, off);
    if (lane == 0) RSTD[row] = rsqrtf(ss / (float)DM + EPS);
  }
}

__device__ void phase_filt_k(const Params& p) {
  const float* H2 = (const float*)(p.ws + OFF_H2); float* KF = (float*)(p.ws + OFF_KF);
  for (int idx = blockIdx.x * NT + threadIdx.x; idx < 2048 * L; idx += gridDim.x * NT) {
    const int t = idx & (L - 1), col = idx >> 12;
    const int o = col >> 10, dir = (col >> 9) & 1, c = col & 511;
    float acc = 0.f;
    for (int j = 0; j < 64; ++j) acc += H2[t * 64 + j] * p.w_f3[j * 2048 + col];
    const float MIN_DECAY = -3.0701134573253944f, MAX_DECAY = -15.350567286626972f;
    float delta = fabsf(MIN_DECAY + (MAX_DECAY - MIN_DECAY) * ((float)c / 511.f));
    float tl = (float)t / (float)(L - 1);
    KF[((size_t)((o * 512 + c) * 2 + dir)) * L + t] = acc * expf(-tl * delta);
  }
}

__device__ __forceinline__ int swz(int row, int chunk) { return row * 128 + ((chunk ^ ((row >> 1) & 7)) << 4); }
template <int CA, int CB> __device__ __forceinline__ void gemm_gload(u32x4 (&ra)[CA], u32x4 (&rb)[CB], const bfr* __restrict__ Ag, const bfr* __restrict__ Bg, int lda, int ldb, int kt) {
#pragma unroll
  for (int i = 0; i < CA; ++i) ra[i] = *(const u32x4*)(Ag + (size_t)i * 64 * lda + kt * 64);
#pragma unroll
  for (int i = 0; i < CB; ++i) rb[i] = *(const u32x4*)(Bg + (size_t)i * 64 * ldb + kt * 64);
}
template <int CA, int CB> __device__ __forceinline__ void gemm_swrite(const u32x4 (&ra)[CA], const u32x4 (&rb)[CB], char* as_, int AB, int srow, int sch) {
  char* bs_ = as_ + AB;
#pragma unroll
  for (int i = 0; i < CA; ++i) *(u32x4*)(as_ + swz(srow + 64 * i, sch)) = ra[i];
#pragma unroll
  for (int i = 0; i < CB; ++i) *(u32x4*)(bs_ + swz(srow + 64 * i, sch)) = rb[i];
}
template <int MI, int NI, int WM, int WN, bool SWAP>
__device__ __forceinline__ void gemm_main(const bfr* __restrict__ A, int lda, const bfr* __restrict__ Bt, int ldb, int nk, char* smem, f32x16 (&acc)[MI][NI]) {
  constexpr int BM = 32 * MI * WM, BN = 32 * NI * WN, AB = BM * 128, STG = (BM + BN) * 128, CA = BM / 64, CB = BN / 64;
  static_assert(WM * WN == 8 && 2 * STG <= (int)LDS_BYTES, "8 waves, two stages must fit");
  const int tid = otid(), wid = tid >> 6, lane = tid & 63, r32 = lane & 31, hi = lane >> 5, wm = wid / WN, wn = wid % WN;
  const int srow = tid >> 3, sch = tid & 7;
  const int lp = r32 * 128 + ((hi ^ ((r32 >> 1) & 7)) << 4), aoff = wm * MI * 4096 + lp, boff = AB + wn * NI * 4096 + lp;
  u32x4 ra[CA], rb[CB];
  const bfr* Ag = A + (size_t)srow * lda + sch * 8;
  const bfr* Bg = Bt + (size_t)srow * ldb + sch * 8;
#define GLOAD(kt) gemm_gload<CA, CB>(ra, rb, Ag, Bg, lda, ldb, (kt))
#define SWRITE(buf) gemm_swrite<CA, CB>(ra, rb, smem + (buf) * STG, AB, srow, sch)
  GLOAD(0); SWRITE(0); __syncthreads();
  if (nk > 1) GLOAD(1);
  for (int kt = 0; kt < nk; ++kt) {
    if (kt + 1 < nk) SWRITE((kt + 1) & 1);
    if (kt + 2 < nk) GLOAD(kt + 2);
    const char* st = smem + (kt & 1) * STG;
#pragma unroll
    for (int s = 0; s < 4; ++s) {
      bf16x8 a[MI], b[NI];
#pragma unroll
      for (int mi = 0; mi < MI; ++mi) a[mi] = *(const bf16x8*)(st + (aoff ^ (s << 5)) + mi * 4096);
#pragma unroll
      for (int ni = 0; ni < NI; ++ni) b[ni] = *(const bf16x8*)(st + (boff ^ (s << 5)) + ni * 4096);
#pragma unroll
      for (int mi = 0; mi < MI; ++mi)
#pragma unroll
        for (int ni = 0; ni < NI; ++ni)
          acc[mi][ni] = SWAP ? __builtin_amdgcn_mfma_f32_32x32x16_bf16(b[ni], a[mi], acc[mi][ni], 0, 0, 0)
                             : __builtin_amdgcn_mfma_f32_32x32x16_bf16(a[mi], b[ni], acc[mi][ni], 0, 0, 0);
    }
    __syncthreads();
  }
#undef GLOAD
#undef SWRITE
}

__device__ void phase_inproj(const Params& p, char* smem) {
  char* ws = p.ws;
  const bfr* XB = (const bfr*)(ws + OFF_XB); const bfr* WIN = (const bfr*)(ws + OFF_WIN); const float* rstd = (const float*)(ws + OFF_RSTD);
  bfr* HYT = (bfr*)(ws + OFF_HYT); bfr* P2 = (bfr*)(ws + OFF_P2); bfr* GATES = (bfr*)p.out;
  const int tid_ = otid(), wid = tid_ >> 6, lane = tid_ & 63, r32 = lane & 31, hi = lane >> 5, wm = wid >> 2, wn = wid & 3;
  constexpr int NTN = INCP / 256, NTM = NTOK / 256;
  for (int it = blockIdx.x; it < NTN * NTM; it += gridDim.x) {
    const int tn = it % NTN, tm = it / NTN, m0 = tm * 256, n0 = tn * 256;
    f32x16 acc[4][2];
#pragma unroll
    for (int mi = 0; mi < 4; ++mi)
#pragma unroll
      for (int ni = 0; ni < 2; ++ni) acc[mi][ni] = f32x16{};
    if (n0 < 2048) {
      gemm_main<4, 2, 2, 4, true>(XB + (size_t)m0 * DM, DM, WIN + (size_t)n0 * DM, DM, DM / 64, smem, acc);
      const int b = m0 >> 12, l0 = (m0 & 4095) + wm * 128 + r32;
#pragma unroll
      for (int mi = 0; mi < 4; ++mi) {
        const float rs = rstd[m0 + wm * 128 + mi * 32 + r32];
#pragma unroll
        for (int ni = 0; ni < 2; ++ni) {
          bfr* dst = HYT + ((size_t)(b * 2048 + n0 + wn * 64 + ni * 32 + 4 * hi)) * L + l0 + mi * 32;
#pragma unroll
          for (int r = 0; r < 16; ++r) dst[(size_t)((r & 3) + 8 * (r >> 2)) * L] = f2bf(acc[mi][ni][r] * rs);
        }
      }
    } else {
      gemm_main<4, 2, 2, 4, false>(XB + (size_t)m0 * DM, DM, WIN + (size_t)n0 * DM, DM, DM / 64, smem, acc);
#pragma unroll
      for (int mi = 0; mi < 4; ++mi) {
#pragma unroll
        for (int ni = 0; ni < 2; ++ni) {
          const int nc = n0 + wn * 64 + ni * 32;
          const int mrow = m0 + wm * 128 + mi * 32 + 4 * hi;
          if (nc < 3232) {
            bfr* dst = P2 + (size_t)mrow * P2W + (nc - 2048) + r32;
#pragma unroll
            for (int r = 0; r < 16; ++r) { const int ro = (r & 3) + 8 * (r >> 2); dst[(size_t)ro * P2W] = f2bf(acc[mi][ni][r] * rstd[mrow + ro]); }
          } else if (nc < INC) {
            bfr* dst = GATES + (size_t)mrow * 2048 + (nc - 3232) + r32;
            const float bg = p.b_gate[nc - 3232 + r32];
#pragma unroll
            for (int r = 0; r < 16; ++r) { const int ro = (r & 3) + 8 * (r >> 2); dst[(size_t)ro * 2048] = f2bf(sigmoidf_(acc[mi][ni][r] * rstd[mrow + ro] + bg)); }
          }
        }
      }
    }
  }
}

using u32x2 = __attribute__((ext_vector_type(2))) unsigned;
__device__ __forceinline__ float swap_add(float x) {
  auto rr = __builtin_amdgcn_permlane32_swap(__float_as_uint(x), __float_as_uint(x), false, false);
  return __uint_as_float(rr[0]) + __uint_as_float(rr[1]);
}
template <int N8> __device__ __forceinline__ float sumsq_bf16(const bfr* __restrict__ p) {
  float s = 0.f;
#pragma unroll 4
  for (int i = 0; i < N8; ++i) {
    const u32x4 v = *(const u32x4*)(p + 8 * i);
#pragma unroll
    for (int j = 0; j < 4; ++j) { const float a = __uint_as_float(v[j] << 16), b = __uint_as_float(v[j] & 0xffff0000u); s += a * a + b * b; }
  }
  return s;
}
__device__ void phase_qkv(const Params& p, char* smem) {
  char* ws = p.ws;
  const bfr* P2 = (const bfr*)(ws + OFF_P2); const float* rope = (const float*)(ws + OFF_ROPE);
  const bfr* WUQ = (const bfr*)(ws + OFF_WUQ); const bfr* WUKV = (const bfr*)(ws + OFF_WUKV);
  bfr* Q = (bfr*)(ws + OFF_Q); bfr* K = (bfr*)(ws + OFF_K); bfr* V = (bfr*)(ws + OFF_V);
  const int tid_ = otid(), wid = tid_ >> 6, lane = tid_ & 63, r32 = lane & 31, hi = lane >> 5;
  constexpr int NQ = (NTOK / 128) * 2, NKV = (NTOK / 256) * 4;
  for (int it = blockIdx.x; it < NQ; it += gridDim.x) {
    {
      const int tn = it & 1, tm = it >> 1, m0 = tm * 128, wm = wid >> 2, wn = wid & 3, head = tn * 4 + wn;
      f32x16 acc[2][3];
#pragma unroll
      for (int mi = 0; mi < 2; ++mi)
#pragma unroll
        for (int ni = 0; ni < 3; ++ni) acc[mi][ni] = f32x16{};
      float rsv[2];
#pragma unroll
      for (int mi = 0; mi < 2; ++mi)
        rsv[mi] = rsqrtf(swap_add(sumsq_bf16<24>(P2 + (size_t)(m0 + wm * 64 + mi * 32 + r32) * P2W + P2_CQ + hi * 192)) / (float)QL + EPS);
      SBAR();
      gemm_main<2, 3, 2, 4, true>(P2 + (size_t)m0 * P2W + P2_CQ, P2W, WUQ + (size_t)tn * 384 * QL, QL, QL / 64, smem, acc);
#pragma unroll
      for (int mi = 0; mi < 2; ++mi) {
        SBAR();
        int hi4 = 4 * hi; asm volatile("" : "+v"(hi4));
        const int tok = m0 + wm * 64 + mi * 32 + r32, b = tok >> 12, l = tok & 4095;
        const float rs = rsv[mi];
        float s2 = 0.f;
#pragma unroll
        for (int ni = 0; ni < 3; ++ni)
#pragma unroll
          for (int r = 0; r < 16; ++r) { const float v = acc[mi][ni][r] * rs; acc[mi][ni][r] = v; s2 += v * v; }
        const float r2 = rsqrtf(swap_add(s2) / (float)QKD + EPS);
#pragma unroll
        for (int ni = 0; ni < 3; ++ni)
#pragma unroll
          for (int g = 0; g < 4; ++g) {
            const float4 gg = *(const float4*)(p.g_qn + ni * 32 + 8 * g + hi4);
            acc[mi][ni][4 * g] *= r2 * gg.x; acc[mi][ni][4 * g + 1] *= r2 * gg.y; acc[mi][ni][4 * g + 2] *= r2 * gg.z; acc[mi][ni][4 * g + 3] *= r2 * gg.w;
          }
#pragma unroll
        for (int r = 0; r < 8; ++r) {
          const float2 cs = *(const float2*)(rope + (l * 16 + crow(r, hi)) * 2);
          const float t1 = acc[mi][2][r], t2 = acc[mi][2][r + 8];
          acc[mi][2][r] = t1 * cs.x - t2 * cs.y; acc[mi][2][r + 8] = t1 * cs.y + t2 * cs.x;
        }
        bfr* q = Q + ((size_t)((b * NH + head) * L + l)) * QKD + 4 * hi;
#pragma unroll
        for (int ni = 0; ni < 3; ++ni)
#pragma unroll
          for (int g = 0; g < 4; ++g) {
            u32x2 w = {cvtpk(acc[mi][ni][4 * g], acc[mi][ni][4 * g + 1]), cvtpk(acc[mi][ni][4 * g + 2], acc[mi][ni][4 * g + 3])};
            *(u32x2*)(q + ni * 32 + 8 * g) = w;
          }
      }
    }
  }
  for (int i2 = blockIdx.x; i2 < NKV; i2 += gridDim.x) {
    {
      const int tn = i2 & 3, tm = i2 >> 2, m0 = tm * 256, wm = wid >> 1, wn = wid & 1, head = tn * 2 + wn;
      f32x16 acc[2][4];
#pragma unroll
      for (int mi = 0; mi < 2; ++mi)
#pragma unroll
        for (int ni = 0; ni < 4; ++ni) acc[mi][ni] = f32x16{};
      float rsv[2];
#pragma unroll
      for (int mi = 0; mi < 2; ++mi)
        rsv[mi] = rsqrtf(swap_add(sumsq_bf16<16>(P2 + (size_t)(m0 + wm * 64 + mi * 32 + r32) * P2W + P2_CKV + hi * 128)) / (float)KVL + EPS);
      SBAR();
      gemm_main<2, 4, 4, 2, true>(P2 + (size_t)m0 * P2W + P2_CKV, P2W, WUKV + (size_t)tn * 256 * KVL, KVL, KVL / 64, smem, acc);
#pragma unroll
      for (int mi = 0; mi < 2; ++mi) {
        SBAR();
        int hi4 = 4 * hi; asm volatile("" : "+v"(hi4));
        const int tok = m0 + wm * 64 + mi * 32 + r32, b = tok >> 12, l = tok & 4095;
        const bfr* prow = P2 + (size_t)tok * P2W;
        const float rs = rsv[mi];
        float kr[16];
#pragma unroll
        for (int g = 0; g < 4; ++g) {
          const u32x2 w = *(const u32x2*)(prow + P2_KR + 8 * g + 4 * hi);
          kr[4 * g] = __uint_as_float(w[0] << 16); kr[4 * g + 1] = __uint_as_float(w[0] & 0xffff0000u);
          kr[4 * g + 2] = __uint_as_float(w[1] << 16); kr[4 * g + 3] = __uint_as_float(w[1] & 0xffff0000u);
        }
        float s2 = 0.f;
#pragma unroll
        for (int ni = 0; ni < 4; ++ni)
#pragma unroll
          for (int r = 0; r < 16; ++r) { const float v = acc[mi][ni][r] * rs; acc[mi][ni][r] = v; if (ni < 2) s2 += v * v; }
#pragma unroll
        for (int r = 0; r < 16; ++r) s2 += kr[r] * kr[r];
        const float r2 = rsqrtf(swap_add(s2) / (float)QKD + EPS);
#pragma unroll
        for (int ni = 0; ni < 2; ++ni)
#pragma unroll
          for (int g = 0; g < 4; ++g) {
            const float4 gg = *(const float4*)(p.g_kn + ni * 32 + 8 * g + hi4);
            acc[mi][ni][4 * g] *= r2 * gg.x; acc[mi][ni][4 * g + 1] *= r2 * gg.y; acc[mi][ni][4 * g + 2] *= r2 * gg.z; acc[mi][ni][4 * g + 3] *= r2 * gg.w;
          }
#pragma unroll
        for (int g = 0; g < 4; ++g) {
          const float4 gg = *(const float4*)(p.g_kn + 64 + 8 * g + hi4);
          kr[4 * g] *= r2 * gg.x; kr[4 * g + 1] *= r2 * gg.y; kr[4 * g + 2] *= r2 * gg.z; kr[4 * g + 3] *= r2 * gg.w;
        }
#pragma unroll
        for (int r = 0; r < 8; ++r) {
          const float2 cs = *(const float2*)(rope + (l * 16 + crow(r, hi)) * 2);
          const float t1 = kr[r], t2 = kr[r + 8];
          kr[r] = t1 * cs.x - t2 * cs.y; kr[r + 8] = t1 * cs.y + t2 * cs.x;
        }
        bfr* kp = K + ((size_t)((b * NH + head) * L + l)) * KPAD + 4 * hi;
#pragma unroll
        for (int ni = 0; ni < 2; ++ni)
#pragma unroll
          for (int g = 0; g < 4; ++g) {
            u32x2 w = {cvtpk(acc[mi][ni][4 * g], acc[mi][ni][4 * g + 1]), cvtpk(acc[mi][ni][4 * g + 2], acc[mi][ni][4 * g + 3])};
            *(u32x2*)(kp + ni * 32 + 8 * g) = w;
          }
#pragma unroll
        for (int g = 0; g < 4; ++g) {
          u32x2 w = {cvtpk(kr[4 * g], kr[4 * g + 1]), cvtpk(kr[4 * g + 2], kr[4 * g + 3])};
          *(u32x2*)(kp + 64 + 8 * g) = w;
        }
        bfr* vp = V + ((size_t)((b * NH + head) * L + l)) * VD + 4 * hi;
#pragma unroll
        for (int ni = 2; ni < 4; ++ni)
#pragma unroll
          for (int g = 0; g < 4; ++g) {
            u32x2 w = {cvtpk(acc[mi][ni][4 * g], acc[mi][ni][4 * g + 1]), cvtpk(acc[mi][ni][4 * g + 2], acc[mi][ni][4 * g + 3])};
            *(u32x2*)(vp + (ni - 2) * 32 + 8 * g) = w;
          }
      }
    }
  }
}

constexpr int AT_SHM_V = 64 * VD * 2, AT_SHM_K = 64 * KPAD * 2;
constexpr float AT_SCALE = 0.10206207261596575f;
constexpr float AT_THR = 8.f;
#define KSWZ(row, colB) ((row) * 256 + ((colB) ^ (((row) & 7) << 4)))
__device__ __forceinline__ void partialSM(f32x16& p0, f32x16& p1, float& m_reg, float& mn, float& alpha) {
  constexpr float C = AT_SCALE * 1.4426950408889634f;
  float pmax = p0[0];
#pragma unroll
  for (int r = 1; r < 16; ++r) pmax = fmaxf(pmax, p0[r]);
#pragma unroll
  for (int r = 0; r < 16; ++r) pmax = fmaxf(pmax, p1[r]);
  { auto rr = __builtin_amdgcn_permlane32_swap(__float_as_uint(pmax), __float_as_uint(pmax), false, false);
    pmax = fmaxf(__uint_as_float(rr[0]), __uint_as_float(rr[1])); }
  if (__builtin_expect(__all(pmax - m_reg <= AT_THR / AT_SCALE), 1)) { mn = m_reg; alpha = 1.f; }
  else { mn = fmaxf(m_reg, pmax); alpha = __builtin_amdgcn_exp2f((m_reg - mn) * C); m_reg = mn; }
  float mnC = -mn * C;
#pragma unroll
  for (int r = 0; r < 16; ++r) p0[r] = fmaf(p0[r], C, mnC);
#pragma unroll
  for (int r = 0; r < 16; ++r) p1[r] = fmaf(p1[r], C, mnC);
#pragma unroll
  for (int r = 0; r < 16; ++r) p0[r] = __builtin_amdgcn_exp2f(p0[r]);
}
__device__ __forceinline__ void finishSM(f32x16& p0, f32x16& p1, float alpha, float& l_reg, bf16x8& pa0, bf16x8& pa1, bf16x8& pa2, bf16x8& pa3) {
#pragma unroll
  for (int r = 0; r < 16; ++r) p1[r] = __builtin_amdgcn_exp2f(p1[r]);
  float ps = 0;
#pragma unroll
  for (int r = 0; r < 16; ++r) ps += p0[r];
#pragma unroll
  for (int r = 0; r < 16; ++r) ps += p1[r];
  { auto rr = __builtin_amdgcn_permlane32_swap(__float_as_uint(ps), __float_as_uint(ps), false, false);
    ps = __uint_as_float(rr[0]) + __uint_as_float(rr[1]); }
  l_reg = l_reg * alpha + ps;
#define PK4(P, BASE, OUT) do { unsigned a0 = cvtpk(P[BASE + 0], P[BASE + 1]), a1 = cvtpk(P[BASE + 2], P[BASE + 3]);   \
    unsigned b0 = cvtpk(P[BASE + 4], P[BASE + 5]), b1 = cvtpk(P[BASE + 6], P[BASE + 7]);                              \
    auto r0 = __builtin_amdgcn_permlane32_swap(a0, b0, false, false); auto r1 = __builtin_amdgcn_permlane32_swap(a1, b1, false, false); \
    u32x4 w = {r0[0], r1[0], r0[1], r1[1]}; OUT = *reinterpret_cast<bf16x8*>(&w); } while (0)
  PK4(p0, 0, pa0); PK4(p0, 8, pa1); PK4(p1, 0, pa2); PK4(p1, 8, pa3);
#undef PK4
}
__device__ __forceinline__ void qkt(f32x16& p0, f32x16& p1, const char* Ks, const bf16x8* qr, int r32, int hi) {
  p0 = f32x16{}; p1 = f32x16{};
#pragma unroll
  for (int d0 = 0; d0 < 6; ++d0) { int cb = (d0 * 16 + hi * 8) * 2;
    bf16x8 b0 = *reinterpret_cast<const bf16x8*>(Ks + KSWZ(r32, cb));
    bf16x8 b1 = *reinterpret_cast<const bf16x8*>(Ks + KSWZ(32 + r32, cb));
    p0 = __builtin_amdgcn_mfma_f32_32x32x16_bf16(b0, qr[d0], p0, 0, 0, 0);
    p1 = __builtin_amdgcn_mfma_f32_32x32x16_bf16(b1, qr[d0], p1, 0, 0, 0); }
}
__device__ __forceinline__ int v_st(int k, int c) { const int kk = (k & ~0xC) | ((k & 4) << 1) | ((k & 8) >> 1); return ((kk >> 3) * 2 + (c >> 5)) * 512 + ((kk & 7) * 32 + (c & 31)) * 2; }
__device__ __forceinline__ int v_rd_base(int lane) { return ((lane & 3) << 3) | (((lane >> 2) & 3) << 6) | (((lane >> 4) & 1) << 5) | (((lane >> 5) & 1) << 8); }
constexpr int v_rd_off(int d0, int ks, int half) { return d0 * 512 + ks * 2048 + half * 1024; }
template <int OFF> __device__ __forceinline__ s16x4 tr_read(int vb) {
  s16x4 r; asm volatile("ds_read_b64_tr_b16 %0, %1 offset:%2" : "=&v"(r) : "v"(vb), "i"(OFF) : "memory"); return r;
}
template <int D0> __device__ __forceinline__ void pv_one(f32x16& od, int vb, bf16x8 pa0, bf16x8 pa1, bf16x8 pa2, bf16x8 pa3) {
  const s16x4 l0 = tr_read<v_rd_off(D0, 0, 0)>(vb), h0 = tr_read<v_rd_off(D0, 0, 1)>(vb), l1 = tr_read<v_rd_off(D0, 1, 0)>(vb), h1 = tr_read<v_rd_off(D0, 1, 1)>(vb);
  const s16x4 l2 = tr_read<v_rd_off(D0, 2, 0)>(vb), h2 = tr_read<v_rd_off(D0, 2, 1)>(vb), l3 = tr_read<v_rd_off(D0, 3, 0)>(vb), h3 = tr_read<v_rd_off(D0, 3, 1)>(vb);
  asm volatile("s_waitcnt lgkmcnt(0)" ::: "memory"); SBAR();
#define PK(LL, HH) (bf16x8){LL[0], LL[1], LL[2], LL[3], HH[0], HH[1], HH[2], HH[3]}
  od = __builtin_amdgcn_mfma_f32_32x32x16_bf16(pa0, PK(l0, h0), od, 0, 0, 0);
  od = __builtin_amdgcn_mfma_f32_32x32x16_bf16(pa1, PK(l1, h1), od, 0, 0, 0);
  od = __builtin_amdgcn_mfma_f32_32x32x16_bf16(pa2, PK(l2, h2), od, 0, 0, 0);
  od = __builtin_amdgcn_mfma_f32_32x32x16_bf16(pa3, PK(l3, h3), od, 0, 0, 0);
#undef PK
}
__device__ __forceinline__ void pv_d0(f32x16* o, int vb, bf16x8 pa0, bf16x8 pa1, bf16x8 pa2, bf16x8 pa3) {
  pv_one<0>(o[0], vb, pa0, pa1, pa2, pa3); pv_one<1>(o[1], vb, pa0, pa1, pa2, pa3);
}
__device__ __forceinline__ void attn_body(const bfr* __restrict__ Qb, const bfr* __restrict__ Kh, const bfr* __restrict__ Vh,
                                          const bfr* __restrict__ za, bfr* __restrict__ op, char* lds) {
  const int tid = otid(), wid = tid >> 6, lane = tid & 63, r32 = lane & 31, hi = lane >> 5;
  char* V_lds = lds; char* K_lds = lds + 2 * AT_SHM_V;
  float* wsm = (float*)(lds + 2 * AT_SHM_V + 2 * AT_SHM_K) + wid * 64; float* li_l = wsm; float* al_l = wsm + 32;
  float m_reg = -1e30f, l_reg = 0; f32x16 o[2] = {}; bf16x8 qr[6];
  const bfr* Qw = Qb + (long)(wid * 32 + r32) * QKD + hi * 8;
#pragma unroll
  for (int d0 = 0; d0 < 6; ++d0) qr[d0] = *reinterpret_cast<const bf16x8*>(Qw + d0 * 16);
  const int sr = tid >> 4, sc = (tid & 15) * 8, vr = tid >> 3, vc = (tid & 7) * 8, vst0 = v_st(vr, vc);
  const int vb0 = (int)(uintptr_t)V_lds + v_rd_base(lane);
  struct { bf16x8 vs0, ks0, ks1; } sr_[2];
#define SLOAD(i, k0) do { sr_[i].vs0 = *reinterpret_cast<const bf16x8*>(&Vh[(long)((k0) + vr) * VD + vc]); \
    sr_[i].ks0 = *reinterpret_cast<const bf16x8*>(&Kh[(long)((k0) + sr) * KPAD + sc]); sr_[i].ks1 = *reinterpret_cast<const bf16x8*>(&Kh[(long)((k0) + 32 + sr) * KPAD + sc]); } while (0)
#define SWRITE(b, i) do { *(bf16x8*)(V_lds + (b) * AT_SHM_V + vst0) = sr_[i].vs0; int kc = sc * 2;               \
    *(bf16x8*)(K_lds + (b) * AT_SHM_K + KSWZ(sr, kc)) = sr_[i].ks0;                       \
    *(bf16x8*)(K_lds + (b) * AT_SHM_K + KSWZ(32 + sr, kc)) = sr_[i].ks1; } while (0)
#define SWAIT() asm volatile("s_waitcnt vmcnt(3)" ::: "memory")
#define RESC(a) do { if (__any((a) < 1.f)) { if (hi == 0) al_l[r32] = (a); asm volatile("s_waitcnt lgkmcnt(0)" ::: "memory"); \
    for (int d = 0; d < 2; ++d) for (int r = 0; r < 16; ++r) o[d][r] *= al_l[crow(r, hi)]; } } while (0)
  f32x16 pA0, pA1, pB0, pB1; float mnA, mnB, alA, alB; bf16x8 pa0, pa1, pa2, pa3; constexpr int NTL = L / 64;
  constexpr int SE = 0, SO = 1;
  SLOAD(SE, 0); asm volatile("s_waitcnt vmcnt(0)" ::: "memory"); SWRITE(0, SE); __syncthreads();
  qkt(pA0, pA1, K_lds, qr, r32, hi); partialSM(pA0, pA1, m_reg, mnA, alA);
  SLOAD(SO, 64); SLOAD(SE, 128);
  SWAIT(); SWRITE(1, SO); __syncthreads();
  for (int j = 1; j + 1 < NTL; j += 2) {
    SBAR(); qkt(pB0, pB1, K_lds + AT_SHM_K, qr, r32, hi);
    finishSM(pA0, pA1, alA, l_reg, pa0, pa1, pa2, pa3); SBAR();
    SLOAD(SO, (j + 2) * 64); SBAR();
    pv_d0(o, vb0, pa0, pa1, pa2, pa3); partialSM(pB0, pB1, m_reg, mnB, alB);
    __syncthreads(); SWAIT(); SWRITE(0, SE);
    RESC(alB); __syncthreads();
    SBAR(); qkt(pA0, pA1, K_lds, qr, r32, hi);
    finishSM(pB0, pB1, alB, l_reg, pa0, pa1, pa2, pa3); SBAR();
    if (j + 3 < NTL) SLOAD(SE, (j + 3) * 64); SBAR();
    pv_d0(o, vb0 + AT_SHM_V, pa0, pa1, pa2, pa3); partialSM(pA0, pA1, m_reg, mnA, alA);
    __syncthreads(); SWAIT(); SWRITE(1, SO);
    RESC(alA); __syncthreads();
  }
  SBAR(); qkt(pB0, pB1, K_lds + AT_SHM_K, qr, r32, hi);
  finishSM(pA0, pA1, alA, l_reg, pa0, pa1, pa2, pa3); SBAR();
  pv_d0(o, vb0, pa0, pa1, pa2, pa3); partialSM(pB0, pB1, m_reg, mnB, alB);
  __syncthreads(); RESC(alB);
  finishSM(pB0, pB1, alB, l_reg, pa0, pa1, pa2, pa3); SBAR();
  pv_d0(o, vb0 + AT_SHM_V, pa0, pa1, pa2, pa3);
  if (hi == 0) li_l[r32] = l_reg; asm volatile("s_waitcnt lgkmcnt(0)" ::: "memory");
  float rli[16];
#pragma unroll
  for (int r = 0; r < 16; ++r) rli[r] = __builtin_amdgcn_rcpf(li_l[crow(r, hi)]);
  int row0 = wid * 32 + 4 * hi; asm volatile("" : "+v"(row0));
  const bfr* zr = za + row0 * P2W + r32; bfr* orp = op + row0 * HY + r32;
#pragma unroll
  for (int r = 0; r < 16; ++r) { const int ro = (r & 3) + 8 * (r >> 2);
#pragma unroll
    for (int d0 = 0; d0 < 2; ++d0) {
      const float z = bf2f(zr[ro * P2W + d0 * 32]);
      orp[ro * HY + d0 * 32] = f2bf(o[d0][r] * rli[r] * siluf_(z)); } }
#undef SLOAD
#undef SWRITE
#undef SWAIT
#undef RESC
}
__device__ void phase_attn(const Params& p, char* smem) {
  char* ws = p.ws;
  const bfr* Q = (const bfr*)(ws + OFF_Q); const bfr* K = (const bfr*)(ws + OFF_K); const bfr* V = (const bfr*)(ws + OFF_V);
  const bfr* P2 = (const bfr*)(ws + OFF_P2); bfr* AAT = (bfr*)(ws + OFF_AAT);
  constexpr int NQB = L / 256, NIT = NQB * NB * NH;
  for (int it = blockIdx.x; it < NIT; it += gridDim.x) {
    const int bh = it / NQB, qb = it % NQB, b = bh >> 3, h = bh & 7;
    const size_t tok0 = (size_t)b * L + qb * 256;
    __syncthreads();
    attn_body(Q + ((size_t)bh * L + qb * 256) * QKD, K + (size_t)bh * L * KPAD, V + (size_t)bh * L * VD,
              P2 + tok0 * P2W + P2_ZA + h * VD, AAT + tok0 * HY + h * VD, smem);
  }
}

__device__ __forceinline__ float2 cmul(float2 a, float2 b) { return make_float2(a.x * b.x - a.y * b.y, a.x * b.y + a.y * b.x); }
__device__ __forceinline__ float2 cmulc(float2 a, float2 b) { return make_float2(a.x * b.x + a.y * b.y, a.y * b.x - a.x * b.y); }
__device__ __forceinline__ constexpr int br4(int r) { return ((r & 1) << 3) | ((r & 2) << 1) | ((r & 4) >> 1) | ((r & 8) >> 3); }
template <bool INV> __device__ __forceinline__ float2 tw16(float2 v, int j) {
  const float C1 = 0.92387953251128674f, S1 = 0.38268343236508977f, R = 0.70710678118654752f;
  float c, s;
  switch (j) { case 0: return v;
    case 1: c = C1; s = S1; break; case 2: c = R; s = R; break; case 3: c = S1; s = C1; break;
    case 4: return INV ? make_float2(-v.y, v.x) : make_float2(v.y, -v.x);
    case 5: c = -S1; s = C1; break; case 6: c = -R; s = R; break; default: c = -C1; s = S1; break; }
  if (INV) s = -s;
  return make_float2(v.x * c + v.y * s, v.y * c - v.x * s);
}
__device__ __forceinline__ void fft16_dif(float2 (&a)[16]) {
#pragma unroll
  for (int s = 0; s < 4; ++s) {
    const int half = 8 >> s;
#pragma unroll
    for (int start = 0; start < 16; start += 2 * half) {
#pragma unroll
      for (int j = 0; j < half; ++j) {
        float2 u = a[start + j], v = a[start + j + half];
        a[start + j] = make_float2(u.x + v.x, u.y + v.y);
        a[start + j + half] = tw16<false>(make_float2(u.x - v.x, u.y - v.y), j * (8 / half));
      }
    }
  }
}
__device__ __forceinline__ void ifft16_dit(float2 (&a)[16]) {
#pragma unroll
  for (int s = 3; s >= 0; --s) {
    const int half = 8 >> s;
#pragma unroll
    for (int start = 0; start < 16; start += 2 * half) {
#pragma unroll
      for (int j = 0; j < half; ++j) {
        float2 pp = a[start + j], q = tw16<true>(a[start + j + half], j * (8 / half));
        a[start + j] = make_float2(pp.x + q.x, pp.y + q.y);
        a[start + j + half] = make_float2(pp.x - q.x, pp.y - q.y);
      }
    }
  }
}
__device__ __forceinline__ void hy_fwd(float2* lds, const float2* __restrict__ TW1, const float2* __restrict__ TW2, float2 (&a)[16]) {
  const int tid = threadIdx.x, m = tid & 255, k1 = m >> 4, lo = m & 15;
  float2* base = lds + (tid >> 8) * FLD;
#pragma unroll
  for (int n = 0; n < 16; ++n) a[n] = base[n * 272 + m];
  fft16_dif(a);
#pragma unroll
  for (int r = 0; r < 16; ++r) { const int k = br4(r); base[k * 272 + m] = cmul(a[r], TW1[k * 256 + m]); }
  __syncthreads();
#pragma unroll
  for (int n = 0; n < 16; ++n) a[n] = base[k1 * 272 + n * 16 + lo];
  fft16_dif(a);
  __syncthreads();
#pragma unroll
  for (int r = 0; r < 16; ++r) { const int k = br4(r); base[k1 * 272 + lo * 17 + k] = cmul(a[r], TW2[k * 16 + lo]); }
  __syncthreads();
#pragma unroll
  for (int n = 0; n < 16; ++n) a[n] = base[k1 * 272 + n * 17 + lo];
  fft16_dif(a);
}
__device__ __forceinline__ void hy_inv(float2* lds, const float2* __restrict__ TW1, const float2* __restrict__ TW2, float2 (&a)[16]) {
  const int tid = threadIdx.x, m = tid & 255, k1 = m >> 4, lo = m & 15;
  float2* base = lds + (tid >> 8) * FLD;
  ifft16_dit(a);
#pragma unroll
  for (int n = 0; n < 16; ++n) base[k1 * 272 + n * 17 + lo] = cmulc(a[n], TW2[n * 16 + lo]);
  __syncthreads();
#pragma unroll
  for (int r = 0; r < 16; ++r) a[r] = base[k1 * 272 + lo * 17 + br4(r)];
  ifft16_dit(a);
  __syncthreads();
#pragma unroll
  for (int n = 0; n < 16; ++n) base[k1 * 272 + n * 16 + lo] = cmulc(a[n], TW1[k1 * 256 + 16 * n + lo]);
  __syncthreads();
#pragma unroll
  for (int r = 0; r < 16; ++r) a[r] = base[br4(r) * 272 + m];
  ifft16_dit(a);
#pragma unroll
  for (int n = 0; n < 16; ++n) base[n * 272 + m] = a[n];
  __syncthreads();
}

__device__ void phase_spectra(const Params& p, char* smem) {
  char* ws = p.ws;
  const float* KF = (const float*)(ws + OFF_KF); float2* KS = (float2*)(ws + OFF_KS);
  const float2* TW0 = (const float2*)(ws + OFF_TW0); const float2* TW1 = (const float2*)(ws + OFF_TW1); const float2* TW2 = (const float2*)(ws + OFF_TW2);
  float2* lds = (float2*)smem;
  const int tid = threadIdx.x;
  for (int it = blockIdx.x; it < 2 * HY; it += gridDim.x) {
    const float* kf = KF + (size_t)it * 2 * L;
    __syncthreads();
#pragma unroll
    for (int j = 0; j < 8; ++j) {
      const int i = tid + NT * j, pos = (i >> 8) * 272 + (i & 255);
      const float lo = kf[i], hi = kf[L + (L - 1 - i)];
      lds[pos] = make_float2(lo + hi, 0.f);
      const float2 w = TW0[i]; const float d = lo - hi;
      lds[FLD + pos] = make_float2(d * w.x, d * w.y);
    }
    __syncthreads();
    float2 a[16];
    hy_fwd(lds, TW1, TW2, a);
    float2* ks = KS + (size_t)it * 16 * NT;
#pragma unroll
    for (int r = 0; r < 16; ++r) ks[r * NT + tid] = make_float2(a[r].x * (1.f / 8192.f), a[r].y * (1.f / 8192.f));
  }
}

__device__ __forceinline__ void sconv8(const bfr* __restrict__ seq, int tid, float w0, float w1, float w2, float bb, float (&u)[8]) {
  const bfr* s = seq + 8 * tid;
  const uint4 raw = *(const uint4*)s;
  float in[10];
  in[0] = tid > 0 ? bf2f(s[-1]) : 0.f; in[9] = tid < NT - 1 ? bf2f(s[8]) : 0.f;
  in[1] = __uint_as_float(raw.x << 16); in[2] = __uint_as_float(raw.x & 0xffff0000u);
  in[3] = __uint_as_float(raw.y << 16); in[4] = __uint_as_float(raw.y & 0xffff0000u);
  in[5] = __uint_as_float(raw.z << 16); in[6] = __uint_as_float(raw.z & 0xffff0000u);
  in[7] = __uint_as_float(raw.w << 16); in[8] = __uint_as_float(raw.w & 0xffff0000u);
#pragma unroll
  for (int j = 0; j < 8; ++j) u[j] = w0 * in[j] + w1 * in[j + 1] + w2 * in[j + 2] + bb;
}
__device__ __forceinline__ void ld8bf(const bfr* __restrict__ seq, int tid, float (&u)[8]) {
  const uint4 raw = *(const uint4*)(seq + 8 * tid);
  u[0] = __uint_as_float(raw.x << 16); u[1] = __uint_as_float(raw.x & 0xffff0000u);
  u[2] = __uint_as_float(raw.y << 16); u[3] = __uint_as_float(raw.y & 0xffff0000u);
  u[4] = __uint_as_float(raw.z << 16); u[5] = __uint_as_float(raw.z & 0xffff0000u);
  u[6] = __uint_as_float(raw.w << 16); u[7] = __uint_as_float(raw.w & 0xffff0000u);
}
__device__ __forceinline__ void hy_scatter(float2* lds, const float2* __restrict__ TW0, const float2 (&z)[8]) {
  const int tid = threadIdx.x, pos = (tid >> 5) * 272 + 8 * (tid & 31);
  const float4* tw = (const float4*)(TW0 + 8 * tid);
#pragma unroll
  for (int j = 0; j < 4; ++j) {
    const float4 w = tw[j];
    *(float4*)(lds + pos + 2 * j) = make_float4(z[2 * j].x, z[2 * j].y, z[2 * j + 1].x, z[2 * j + 1].y);
    const float2 o0 = cmul(z[2 * j], make_float2(w.x, w.y)), o1 = cmul(z[2 * j + 1], make_float2(w.z, w.w));
    *(float4*)(lds + FLD + pos + 2 * j) = make_float4(o0.x, o0.y, o1.x, o1.y);
  }
}
__device__ __forceinline__ void hy_gather(const float2* lds, const float2* __restrict__ TW0, float2 (&y)[8]) {
  const int tid = threadIdx.x, pos = (tid >> 5) * 272 + 8 * (tid & 31);
  const float4* tw = (const float4*)(TW0 + 8 * tid);
#pragma unroll
  for (int j = 0; j < 4; ++j) {
    const float4 w = tw[j];
    const float4 e = *(const float4*)(lds + pos + 2 * j), o = *(const float4*)(lds + FLD + pos + 2 * j);
    const float2 t0 = cmulc(make_float2(o.x, o.y), make_float2(w.x, w.y)), t1 = cmulc(make_float2(o.z, o.w), make_float2(w.z, w.w));
    y[2 * j] = make_float2(e.x + t0.x, e.y + t0.y); y[2 * j + 1] = make_float2(e.z + t1.x, e.w + t1.y);
  }
}
__device__ void phase_hyena(const Params& p, char* smem) {
  char* ws = p.ws;
  const bfr* HYT = (const bfr*)(ws + OFF_HYT); const float2* KS = (const float2*)(ws + OFF_KS); bfr* AHY = (bfr*)(ws + OFF_AHY);
  const float2* TW0 = (const float2*)(ws + OFF_TW0); const float2* TW1 = (const float2*)(ws + OFF_TW1); const float2* TW2 = (const float2*)(ws + OFF_TW2);
  float2* lds = (float2*)smem;
  const int tid = threadIdx.x;
  for (int n = 0;; ++n) {
    const int c = blockIdx.x + gridDim.x * (n >> 2), bp = n & 3;
    if (c >= HY) break;
    const int b0 = 2 * bp, b1 = b0 + 1;
    float2 zin[8];
    {
      float u0[8], u1[8];
      const float w0 = p.w_short[c], w1 = p.w_short[1536 + c], w2 = p.w_short[3072 + c], bb = p.b_short[c];
      sconv8(HYT + ((size_t)(b0 * 2048 + c)) * L, tid, w0, w1, w2, bb, u0);
      sconv8(HYT + ((size_t)(b1 * 2048 + c)) * L, tid, w0, w1, w2, bb, u1);
#pragma unroll
      for (int j = 0; j < 8; ++j) zin[j] = make_float2(u0[j], u1[j]);
      __syncthreads();
      hy_scatter(lds, TW0, zin);
      __syncthreads();
    }
#pragma unroll 1
    for (int o = 0; o < 2; ++o) {
      {
        float2 a[16];
        hy_fwd(lds, TW1, TW2, a);
        const float2* ks = KS + (size_t)(o * HY + c) * 16 * NT;
#pragma unroll
        for (int r = 0; r < 16; ++r) a[r] = cmul(a[r], ks[r * NT + tid]);
        hy_inv(lds, TW1, TW2, a);
      }
      __builtin_amdgcn_sched_barrier(0);
      float2 y[8];
      hy_gather(lds, TW0, y);
      const int chg = (o == 0 ? 512 : 1024) + c;
      const float w0 = p.w_short[chg], w1 = p.w_short[1536 + chg], w2 = p.w_short[3072 + chg], bb = p.b_short[chg];
      const float bias = p.hy_bias[o * HY + c];
      float g0[8], g1[8];
      sconv8(HYT + ((size_t)(b0 * 2048 + chg)) * L, tid, w0, w1, w2, bb, g0);
      sconv8(HYT + ((size_t)(b1 * 2048 + chg)) * L, tid, w0, w1, w2, bb, g1);
#pragma unroll
      for (int j = 0; j < 8; ++j) zin[j] = make_float2(g0[j] * (y[j].x + bias * zin[j].x), g1[j] * (y[j].y + bias * zin[j].y));
      __syncthreads();
      if (o == 0) {
        hy_scatter(lds, TW0, zin);
        __syncthreads();
      } else {
        float z0[8], z1[8];
        ld8bf(HYT + ((size_t)(b0 * 2048 + 1536 + c)) * L, tid, z0);
        ld8bf(HYT + ((size_t)(b1 * 2048 + 1536 + c)) * L, tid, z1);
#pragma unroll
        for (int j = 0; j < 8; ++j) {
          const int i = 8 * tid + j;
          AHY[((size_t)(b0 * L + i)) * HY + c] = f2bf(zin[j].x * siluf_(z0[j]));
          AHY[((size_t)(b1 * L + i)) * HY + c] = f2bf(zin[j].y * siluf_(z1[j]));
        }
      }
    }
  }
}

__device__ void phase_out1(const Params& p, char* smem) {
  char* ws = p.ws;
  const bfr* AHY = (const bfr*)(ws + OFF_AHY); const bfr* AAT = (const bfr*)(ws + OFF_AAT); const bfr* WHY = (const bfr*)(ws + OFF_WHY); const bfr* WAT = (const bfr*)(ws + OFF_WAT);
  const bfr* GATES = (const bfr*)p.out; bfr* MRG = (bfr*)(ws + OFF_MRG);
  const int tid_ = otid(), wid = tid_ >> 6, lane = tid_ & 63, r32 = lane & 31, hi = lane >> 5, wm = wid >> 2, wn = wid & 3;
  constexpr int NTN = DM / 128, NTM = NTOK / 256;
  for (int it = blockIdx.x; it < NTN * NTM; it += gridDim.x) {
    const int tn = it % NTN, tm = it / NTN, m0 = tm * 256, n0 = tn * 128;
    f32x16 a1[4][1], a2[4][1];
#pragma unroll
    for (int mi = 0; mi < 4; ++mi) { a1[mi][0] = f32x16{}; a2[mi][0] = f32x16{}; }
    gemm_main<4, 1, 2, 4, false>(AHY + (size_t)m0 * HY, HY, WHY + (size_t)n0 * HY, HY, HY / 64, smem, a1);
    gemm_main<4, 1, 2, 4, false>(AAT + (size_t)m0 * HY, HY, WAT + (size_t)n0 * HY, HY, HY / 64, smem, a2);
    const int nc = n0 + wn * 32 + r32;
#pragma unroll
    for (int mi = 0; mi < 4; ++mi) {
      const int mrow = m0 + wm * 128 + mi * 32 + 4 * hi;
#pragma unroll
      for (int r = 0; r < 16; ++r) {
        const size_t row = mrow + (r & 3) + 8 * (r >> 2);
        const float gh = bf2f(GATES[row * 2048 + nc]), ga = bf2f(GATES[row * 2048 + 1024 + nc]);
        MRG[row * DM + nc] = f2bf(gh * a1[mi][0][r] + ga * a2[mi][0][r]);
      }
    }
  }
}
__device__ void phase_out2(const Params& p, char* smem) {
  char* ws = p.ws;
  const bfr* MRG = (const bfr*)(ws + OFF_MRG); const bfr* WOUT = (const bfr*)(ws + OFF_WOUT);
  const int tid_ = otid(), wid = tid_ >> 6, lane = tid_ & 63, r32 = lane & 31, hi = lane >> 5, wm = wid >> 2, wn = wid & 3;
  constexpr int NTN = DM / 256, NTM = NTOK / 256;
  for (int it = blockIdx.x; it < NTN * NTM; it += gridDim.x) {
    const int tn = it % NTN, tm = it / NTN, m0 = tm * 256, n0 = tn * 256;
    f32x16 acc[4][2];
#pragma unroll
    for (int mi = 0; mi < 4; ++mi)
#pragma unroll
      for (int ni = 0; ni < 2; ++ni) acc[mi][ni] = f32x16{};
    gemm_main<4, 2, 2, 4, false>(MRG + (size_t)m0 * DM, DM, WOUT + (size_t)n0 * DM, DM, DM / 64, smem, acc);
#pragma unroll
    for (int mi = 0; mi < 4; ++mi)
#pragma unroll
      for (int ni = 0; ni < 2; ++ni) {
        const size_t off = (size_t)(m0 + wm * 128 + mi * 32 + 4 * hi) * DM + n0 + wn * 64 + ni * 32 + r32;
#pragma unroll
        for (int r = 0; r < 16; ++r) { const size_t o2 = off + (size_t)((r & 3) + 8 * (r >> 2)) * DM; p.out[o2] = p.x[o2] + acc[mi][ni][r]; }
      }
  }
}

__global__ __launch_bounds__(NT, 1) void fwd_megakernel(Params p) {
  extern __shared__ __attribute__((aligned(16))) char smem[];
  cg::grid_group grid = cg::this_grid();
  phase0(p, smem);
  grid.sync();
  phase_filt_k(p);
  phase_inproj(p, smem);
  grid.sync();
  phase_qkv(p, smem);
  phase_spectra(p, smem);
  grid.sync();
  phase_attn(p, smem);
  phase_hyena(p, smem);
  grid.sync();
  phase_out1(p, smem);
  grid.sync();
  phase_out2(p, smem);
}

extern "C" void kernel_launch(void* const* d_in, const int* in_sizes, int n_in, void* d_out, int out_size, void* d_ws, size_t ws_size, hipStream_t stream) {
  if (ws_size < WS_END) { fprintf(stderr, "kernel_launch: ws too small: %zu < %zu\n", ws_size, WS_END); return; }
  static int grid_blocks = 0;
  if (!grid_blocks) {
    int dev = 0, cus = 0, per_cu = 0;
    hipGetDevice(&dev);
    hipDeviceGetAttribute(&cus, hipDeviceAttributeMultiprocessorCount, dev);
    hipFuncSetAttribute((const void*)fwd_megakernel, hipFuncAttributeMaxDynamicSharedMemorySize, (int)LDS_BYTES);
    hipOccupancyMaxActiveBlocksPerMultiprocessor(&per_cu, fwd_megakernel, NT, LDS_BYTES);
    if (per_cu < 1) { fprintf(stderr, "kernel_launch: occupancy query returned %d\n", per_cu); return; }
    if (per_cu > 1) per_cu = 1;
    grid_blocks = cus * per_cu;
  }
  Params p{};
  const float** f = (const float**)&p;
  for (int i = 0; i < 23; ++i) f[i] = (const float*)d_in[i];
  p.out = (float*)d_out; p.ws = (char*)d_ws;
  void* args[] = {&p};
  hipError_t e = hipLaunchCooperativeKernel((void*)fwd_megakernel, dim3(grid_blocks), dim3(NT), args, LDS_BYTES, stream);
  if (e != hipSuccess) fprintf(stderr, "cooperative launch failed: %s (grid %d)\n", hipGetErrorString(e), grid_blocks);
}
```

```cpp
#include <hip/hip_runtime.h>
#include <hip/hip_cooperative_groups.h>
#include <cstdio>
#include <cstdint>

typedef unsigned short bfr;
using bf16x8 = __attribute__((ext_vector_type(8))) short;
using f32x4  = __attribute__((ext_vector_type(4))) float;
using s16x4  = __attribute__((ext_vector_type(4))) short;
using f32x16 = __attribute__((ext_vector_type(16))) float;
using u32x4  = __attribute__((ext_vector_type(4))) unsigned;
#define SBAR() __builtin_amdgcn_sched_barrier(0)
__device__ __forceinline__ int otid() { int t = threadIdx.x; asm volatile("" : "+v"(t)); return t; }

#define XB_TMO      128
#define XB_XCNT(j)  (256  + 64 * (j))
#define XB_XSUB(j)  (1280 + 64 * (j))
#define XB_XGEN(j)  (2304 + 64 * (j))
#define XB_TOP      3328
#define XB_TOPGEN   3392
#define XCD_BAR_WORDS 3456
#define XB_SPIN_CAP (1u << 18)
#define LAS __attribute__((address_space(3)))
__device__ __forceinline__ unsigned xb_ld(unsigned* p)              { return __hip_atomic_load(p, __ATOMIC_RELAXED, __HIP_MEMORY_SCOPE_AGENT); }
__device__ __forceinline__ unsigned xb_add(unsigned* p, unsigned v) { return __hip_atomic_fetch_add(p, v, __ATOMIC_RELAXED, __HIP_MEMORY_SCOPE_AGENT); }
__device__ __forceinline__ unsigned xb_xcc_id() { return (unsigned)__builtin_amdgcn_s_getreg((3 << 11) | 20) & 0xFu; }
#define XB_SPIN(cond, bar) do { unsigned _sp = 0; while (cond) { __builtin_amdgcn_s_sleep(1); \
    if ((++_sp & 255u) == 0u) { if (xb_ld(&(bar)[XB_TMO])) break; if (_sp > XB_SPIN_CAP) { atomicAdd(&(bar)[XB_TMO], 1u); break; } } } } while (0)
struct XcdBarrier { unsigned* bar; unsigned x; volatile LAS unsigned* st; };
__device__ __forceinline__ XcdBarrier xcd_barrier_post(unsigned* bar, volatile LAS unsigned* st) {
  XcdBarrier b; b.bar = bar; b.x = xb_xcc_id(); b.st = st;
  if (threadIdx.x == 0) (void)xb_add(&bar[XB_XCNT(b.x)], 1u);
  return b;
}
__device__ __forceinline__ void xcd_barrier_complete(unsigned* bar, unsigned x, unsigned& nloc, unsigned& nx) {
  const unsigned G = gridDim.x * gridDim.y * gridDim.z;
  unsigned sum, cnt, mine, sp = 0u;
  for (;;) {
    sum = 0u; cnt = 0u; mine = 0u;
#pragma unroll
    for (unsigned j = 0; j < 16; ++j) { const unsigned c = xb_ld(&bar[XB_XCNT(j)]); sum += c; cnt += (c > 0u) ? 1u : 0u; mine = (j == x) ? c : mine; }
    if (sum == G) break;
    __builtin_amdgcn_s_sleep(1);
    if ((++sp & 255u) == 0u) { if (xb_ld(&bar[XB_TMO])) break; if (sp > XB_SPIN_CAP) { atomicAdd(&bar[XB_TMO], 1u); break; } }
  }
  nloc = mine > 0u ? mine : 1u; nx = cnt > 0u ? cnt : 1u;
}
__device__ __forceinline__ void xcd_barrier(const XcdBarrier& b) {
  asm volatile("s_waitcnt vmcnt(0)" ::: "memory");
  __syncthreads();
  if (threadIdx.x == 0) {
    unsigned* bar = b.bar;
    __builtin_amdgcn_s_waitcnt(0);
    unsigned nloc = b.st[0], nx = b.st[1];
    if (nloc == 0u) { xcd_barrier_complete(bar, b.x, nloc, nx); b.st[0] = nloc; b.st[1] = nx; }
    const unsigned old = xb_add(&bar[XB_XSUB(b.x)], 1u);
    const unsigned gen = old / nloc;
    if (old + 1u == (gen + 1u) * nloc) {
      __builtin_amdgcn_fence(__ATOMIC_RELEASE, "agent");
      asm volatile("s_waitcnt vmcnt(0)" ::: "memory");
      const unsigned og = xb_add(&bar[XB_TOP], 1u);
      const unsigned tg = og / nx;
      if (og + 1u == (tg + 1u) * nx) xb_add(&bar[XB_TOPGEN], 1u);
      else XB_SPIN(xb_ld(&bar[XB_TOPGEN]) == tg, bar);
      __builtin_amdgcn_fence(__ATOMIC_ACQUIRE, "agent");
      xb_add(&bar[XB_XGEN(b.x)], 1u);
      asm volatile("s_waitcnt vmcnt(0)" ::: "memory");
    } else {
      XB_SPIN(xb_ld(&bar[XB_XGEN(b.x)]) == gen, bar);
      __builtin_amdgcn_fence(__ATOMIC_ACQUIRE, "agent");
      asm volatile("s_waitcnt vmcnt(0)" ::: "memory");
    }
  }
  __syncthreads();
}
__device__ __forceinline__ int crow(int r, int hi) { return (r & 3) + 8 * (r >> 2) + 4 * hi; }
__device__ __forceinline__ unsigned cvtpk(float lo, float hi) { unsigned r; asm volatile("v_cvt_pk_bf16_f32 %0, %1, %2" : "=v"(r) : "v"(lo), "v"(hi)); return r; }

constexpr int NB = 8, L = 4096, DM = 1024, NTOK = NB * L;
constexpr int HY = 512, INC = 5280, INCP = 5376;
constexpr int P2W = 1184;
constexpr int P2_CQ = 0, P2_CKV = 384, P2_KR = 640, P2_ZA = 672;
constexpr int NH = 8, QKD = 96, KPAD = 128, VD = 64, QL = 384, KVL = 256;
constexpr float EPS = 1e-6f;
constexpr float PI_F = 3.14159265358979323846f;

constexpr size_t al256(size_t x) { return (x + 255) / 256 * 256; }
constexpr size_t OFF_RSTD = 0;
constexpr size_t OFF_ROPE = OFF_RSTD + al256((size_t)NTOK * 4);
constexpr size_t OFF_H2   = OFF_ROPE + al256((size_t)L * 32 * 4);
constexpr size_t OFF_WIN  = OFF_H2 + al256((size_t)L * 64 * 4);
constexpr size_t OFF_WHY  = OFF_WIN + al256((size_t)INCP * DM * 2);
constexpr size_t OFF_WAT  = OFF_WHY + al256((size_t)DM * HY * 2);
constexpr size_t OFF_WOUT = OFF_WAT + al256((size_t)DM * HY * 2);
constexpr size_t OFF_HYT  = OFF_WOUT + al256((size_t)DM * DM * 2);
constexpr size_t OFF_P2   = OFF_HYT + al256((size_t)NB * 2048 * L * 2);
constexpr size_t OFF_Q    = OFF_P2 + al256((size_t)NTOK * P2W * 2);
constexpr size_t OFF_K    = OFF_Q + al256((size_t)NTOK * NH * QKD * 2);
constexpr size_t OFF_V    = OFF_K + al256((size_t)NTOK * NH * KPAD * 2);
constexpr size_t OFF_KS   = OFF_V + al256((size_t)NTOK * NH * VD * 2);
constexpr size_t OFF_AHY  = OFF_KS + al256((size_t)2 * HY * 16 * 512 * 8);
constexpr size_t OFF_AAT  = OFF_AHY + al256((size_t)NTOK * HY * 2);
constexpr size_t OFF_TW0  = OFF_AAT + al256((size_t)NTOK * HY * 2);
constexpr size_t OFF_TW1  = OFF_TW0 + al256((size_t)4096 * 8);
constexpr size_t OFF_TW2  = OFF_TW1 + al256((size_t)4096 * 8);
constexpr size_t OFF_WUQ  = OFF_TW2 + al256((size_t)256 * 8);
constexpr size_t OFF_WUKV = OFF_WUQ + al256((size_t)NH * QKD * QL * 2);
constexpr size_t OFF_BAR  = OFF_WUKV + al256((size_t)NH * 128 * KVL * 2);
constexpr size_t BAR_BYTES = 3456 * 4;
constexpr size_t WS_END   = OFF_BAR + al256(BAR_BYTES);
constexpr size_t OFF_KF   = OFF_AHY;
constexpr size_t OFF_XB   = OFF_Q;
constexpr size_t OFF_MRG  = OFF_HYT;

__device__ __forceinline__ bfr f2bf(float x) { unsigned u = __float_as_uint(x); u += 0x7fffu + ((u >> 16) & 1u); return (bfr)(u >> 16); }
__device__ __forceinline__ float bf2f(bfr h) { return __uint_as_float(((unsigned)h) << 16); }
__device__ __forceinline__ float sigmoidf_(float x) { return 1.f / (1.f + __expf(-x)); }
__device__ __forceinline__ float siluf_(float x) { return x / (1.f + __expf(-x)); }


namespace cg = cooperative_groups;
#define DUP 0
constexpr int NT = 512;
constexpr int FLD = 16 * 272;
constexpr size_t LDS_PHASE = 131072, LDS_BYTES = LDS_PHASE + 16;

struct Params {
  const float *x, *g_norm, *w_in, *b_gate, *w_short, *b_short, *w_f1, *b_f1, *freq1, *w_f2, *b_f2, *freq2, *w_f3, *hy_bias, *w_hy_out,
              *g_cq, *w_uq, *g_ckv, *w_ukv, *g_qn, *g_kn, *w_attn_out, *w_out;
  float* out; char* ws;
};

__device__ void wT_phase(const float* __restrict__ src, const float* __restrict__ scale, bfr* __restrict__ dst, int K, int N, int NP) {
  const int total = NP * (K / 32);
  for (int i = blockIdx.x * NT + threadIdx.x; i < total; i += gridDim.x * NT) {
    const int kb = i / NP, n = i - kb * NP;
    u32x4 o[4];
    if (n < N) {
      const float* s = src + (size_t)(kb * 32) * N + n;
      float v[32];
#pragma unroll
      for (int j = 0; j < 32; ++j) v[j] = s[(size_t)j * N];
      if (scale) {
#pragma unroll
        for (int j = 0; j < 32; ++j) v[j] *= scale[kb * 32 + j];
      }
#pragma unroll
      for (int j = 0; j < 4; ++j) o[j] = u32x4{cvtpk(v[8 * j], v[8 * j + 1]), cvtpk(v[8 * j + 2], v[8 * j + 3]), cvtpk(v[8 * j + 4], v[8 * j + 5]), cvtpk(v[8 * j + 6], v[8 * j + 7])};
    } else {
#pragma unroll
      for (int j = 0; j < 4; ++j) o[j] = u32x4{0u, 0u, 0u, 0u};
    }
    u32x4* d = (u32x4*)(dst + (size_t)n * K + kb * 32);
#pragma unroll
    for (int j = 0; j < 4; ++j) d[j] = o[j];
  }
}

__device__ void phase0(const Params& p, char* smem) {
  char* ws = p.ws;
  float* ROPE = (float*)(ws + OFF_ROPE); float* H2 = (float*)(ws + OFF_H2); float* RSTD = (float*)(ws + OFF_RSTD);
  bfr* XB = (bfr*)(ws + OFF_XB);
  const int tid = threadIdx.x, wid = tid >> 6, lane = tid & 63;
  for (int idx = blockIdx.x * NT + tid; idx < L * 16; idx += gridDim.x * NT) {
    int l = idx >> 4, j = idx & 15;
    float inv = powf(10000.f, -(float)(2 * j) / 32.f);
    float ang = (float)l * inv;
    ROPE[idx * 2] = cosf(ang); ROPE[idx * 2 + 1] = sinf(ang);
  }
  {
    float2* TW0 = (float2*)(ws + OFF_TW0); float2* TW1 = (float2*)(ws + OFF_TW1); float2* TW2 = (float2*)(ws + OFF_TW2);
    for (int idx = blockIdx.x * NT + tid; idx < 4096 + 4096 + 256; idx += gridDim.x * NT) {
      if (idx < 4096) { float a = (float)idx / 4096.f; TW0[idx] = make_float2(cospif(a), -sinpif(a)); }
      else if (idx < 8192) { int j = idx - 4096; int k1 = j >> 8, m = j & 255; float a = (float)((k1 * m) & 4095) / 2048.f; TW1[j] = make_float2(cospif(a), -sinpif(a)); }
      else { int j = idx - 8192; int k2 = j >> 4, n3 = j & 15; float a = (float)((k2 * n3) & 255) / 128.f; TW2[j] = make_float2(cospif(a), -sinpif(a)); }
    }
  }
  wT_phase(p.w_in, p.g_norm, (bfr*)(ws + OFF_WIN), DM, INC, INCP);
  wT_phase(p.w_hy_out, nullptr, (bfr*)(ws + OFF_WHY), HY, DM, DM);
  wT_phase(p.w_attn_out, nullptr, (bfr*)(ws + OFF_WAT), HY, DM, DM);
  wT_phase(p.w_out, nullptr, (bfr*)(ws + OFF_WOUT), DM, DM, DM);
  wT_phase(p.w_uq, p.g_cq, (bfr*)(ws + OFF_WUQ), QL, NH * QKD, NH * QKD);
  wT_phase(p.w_ukv, p.g_ckv, (bfr*)(ws + OFF_WUKV), KVL, NH * 128, NH * 128);
  {
    float* z = (float*)smem + wid * 128; float* h1 = z + 64;
    for (int it = blockIdx.x; it < L / 8; it += gridDim.x) {
      const int t = it * 8 + wid, j = lane;
      if (j < 33) {
        float v;
        if (j == 0) v = (float)t / (float)(L - 1);
        else { int i = (j - 1) & 15; float f = 1e-4f + (float)i * ((15.f - 1e-4f) / 15.f); float ang = ((2.f * PI_F / (float)L) * (float)t) * f;
               v = (j <= 16) ? cosf(ang) : -sinf(ang); }
        z[j] = v;
      }
      __syncthreads();
      float a = p.b_f1[j];
      for (int i = 0; i < 33; ++i) a += z[i] * p.w_f1[i * 64 + j];
      h1[j] = sinf(p.freq1[j] * a);
      __syncthreads();
      float c = p.b_f2[j];
      for (int i = 0; i < 64; ++i) c += h1[i] * p.w_f2[i * 64 + j];
      H2[t * 64 + j] = sinf(p.freq2[j] * c);
      __syncthreads();
    }
  }
  for (int row = blockIdx.x * 8 + wid; row < NTOK; row += gridDim.x * 8) {
    const float4* px = (const float4*)(p.x + (size_t)row * DM);
    float ss = 0.f;
    for (int i = 0; i < 4; ++i) {
      float4 v = px[lane + 64 * i];
      ss += v.x * v.x + v.y * v.y + v.z * v.z + v.w * v.w;
      ushort4 o; o.x = f2bf(v.x); o.y = f2bf(v.y); o.z = f2bf(v.z); o.w = f2bf(v.w);
      ((ushort4*)(XB + (size_t)row * DM))[lane + 64 * i] = o;
    }
    for (int off = 32; off > 0; off >>= 1) ss += __shfl_xor(ss, off);
    if (lane == 0) RSTD[row] = rsqrtf(ss / (float)DM + EPS);
  }
}

__device__ void phase_filt_k(const Params& p) {
  const float* H2 = (const float*)(p.ws + OFF_H2); float* KF = (float*)(p.ws + OFF_KF);
  const int tid = otid();
  for (int it = blockIdx.x; it < (L / 32) * 4; it += gridDim.x) {
    const int t0 = (it >> 2) * 32, col = (it & 3) * 512 + tid;
    const int o = col >> 10, dir = (col >> 9) & 1, c = col & 511;
    float acc[32];
#pragma unroll
    for (int tt = 0; tt < 32; ++tt) acc[tt] = 0.f;
    const float* h = H2 + t0 * 64;
#pragma unroll 2
    for (int j = 0; j < 64; ++j) {
      const float w = p.w_f3[j * 2048 + col];
#pragma unroll
      for (int tt = 0; tt < 32; ++tt) acc[tt] += h[tt * 64 + j] * w;
    }
    const float MIN_DECAY = -3.0701134573253944f, MAX_DECAY = -15.350567286626972f;
    const float delta = fabsf(MIN_DECAY + (MAX_DECAY - MIN_DECAY) * ((float)c / 511.f));
    float4* dst = (float4*)(KF + ((size_t)((o * 512 + c) * 2 + dir)) * L + t0);
#pragma unroll
    for (int q = 0; q < 8; ++q) {
      float4 v;
      v.x = acc[4 * q] * expf(-((float)(t0 + 4 * q) / (float)(L - 1)) * delta);
      v.y = acc[4 * q + 1] * expf(-((float)(t0 + 4 * q + 1) / (float)(L - 1)) * delta);
      v.z = acc[4 * q + 2] * expf(-((float)(t0 + 4 * q + 2) / (float)(L - 1)) * delta);
      v.w = acc[4 * q + 3] * expf(-((float)(t0 + 4 * q + 3) / (float)(L - 1)) * delta);
      dst[q] = v;
    }
  }
}

__device__ __forceinline__ int swz(int row, int chunk) { return row * 128 + ((chunk ^ ((row >> 1) & 7)) << 4); }
template <int CA, int CB> __device__ __forceinline__ void gemm_gload(u32x4 (&ra)[CA], u32x4 (&rb)[CB], const bfr* __restrict__ Ag, const bfr* __restrict__ Bg, int lda, int ldb, int kt) {
#pragma unroll
  for (int i = 0; i < CA; ++i) ra[i] = *(const u32x4*)(Ag + (size_t)i * 64 * lda + kt * 64);
#pragma unroll
  for (int i = 0; i < CB; ++i) rb[i] = *(const u32x4*)(Bg + (size_t)i * 64 * ldb + kt * 64);
}
template <int CA, int CB> __device__ __forceinline__ void gemm_swrite(const u32x4 (&ra)[CA], const u32x4 (&rb)[CB], char* as_, int AB, int srow, int sch) {
  char* bs_ = as_ + AB;
#pragma unroll
  for (int i = 0; i < CA; ++i) *(u32x4*)(as_ + swz(srow + 64 * i, sch)) = ra[i];
#pragma unroll
  for (int i = 0; i < CB; ++i) *(u32x4*)(bs_ + swz(srow + 64 * i, sch)) = rb[i];
}
template <int MI, int NI, int WM, int WN, bool SWAP>
__device__ __forceinline__ void gemm_main(const bfr* __restrict__ A, int lda, const bfr* __restrict__ Bt, int ldb, int nk, char* smem, f32x16 (&acc)[MI][NI]) {
  constexpr int BM = 32 * MI * WM, BN = 32 * NI * WN, AB = BM * 128, STG = (BM + BN) * 128, CA = BM / 64, CB = BN / 64;
  static_assert(WM * WN == 8 && 2 * STG <= (int)LDS_PHASE, "8 waves, two stages must fit");
  const int tid = otid(), wid = tid >> 6, lane = tid & 63, r32 = lane & 31, hi = lane >> 5, wm = wid / WN, wn = wid % WN;
  const int srow = tid >> 3, sch = tid & 7;
  const int lp = r32 * 128 + ((hi ^ ((r32 >> 1) & 7)) << 4), aoff = wm * MI * 4096 + lp, boff = AB + wn * NI * 4096 + lp;
  u32x4 ra[CA], rb[CB];
  const bfr* Ag = A + (size_t)srow * lda + sch * 8;
  const bfr* Bg = Bt + (size_t)srow * ldb + sch * 8;
#define GLOAD(kt) gemm_gload<CA, CB>(ra, rb, Ag, Bg, lda, ldb, (kt))
#define SWRITE(buf) gemm_swrite<CA, CB>(ra, rb, smem + (buf) * STG, AB, srow, sch)
  GLOAD(0); SWRITE(0); __syncthreads();
  if (nk > 1) GLOAD(1);
  for (int kt = 0; kt < nk; ++kt) {
    if (kt + 1 < nk) SWRITE((kt + 1) & 1);
    if (kt + 2 < nk) GLOAD(kt + 2);
    SBAR();
    const char* st = smem + (kt & 1) * STG;
#pragma unroll
    for (int s = 0; s < 4; ++s) {
      bf16x8 a[MI], b[NI];
#pragma unroll
      for (int mi = 0; mi < MI; ++mi) a[mi] = *(const bf16x8*)(st + (aoff ^ (s << 5)) + mi * 4096);
#pragma unroll
      for (int ni = 0; ni < NI; ++ni) b[ni] = *(const bf16x8*)(st + (boff ^ (s << 5)) + ni * 4096);
#pragma unroll
      for (int mi = 0; mi < MI; ++mi)
#pragma unroll
        for (int ni = 0; ni < NI; ++ni)
          acc[mi][ni] = SWAP ? __builtin_amdgcn_mfma_f32_32x32x16_bf16(b[ni], a[mi], acc[mi][ni], 0, 0, 0)
                             : __builtin_amdgcn_mfma_f32_32x32x16_bf16(a[mi], b[ni], acc[mi][ni], 0, 0, 0);
    }
    __syncthreads();
  }
#undef GLOAD
#undef SWRITE
}

__device__ void phase_inproj(const Params& p, char* smem) {
  char* ws = p.ws;
  const bfr* XB = (const bfr*)(ws + OFF_XB); const bfr* WIN = (const bfr*)(ws + OFF_WIN); const float* rstd = (const float*)(ws + OFF_RSTD);
  bfr* HYT = (bfr*)(ws + OFF_HYT); bfr* P2 = (bfr*)(ws + OFF_P2); bfr* GATES = (bfr*)p.out;
  const int tid_ = otid(), wid = tid_ >> 6, lane = tid_ & 63, r32 = lane & 31, hi = lane >> 5, wm = wid >> 2, wn = wid & 3;
  constexpr int NTN = INCP / 256, NTM = NTOK / 256;
  for (int it = blockIdx.x; it < NTN * NTM; it += gridDim.x) {
    const int tn = it % NTN, tm = it / NTN, m0 = tm * 256, n0 = tn * 256;
    f32x16 acc[4][2];
#pragma unroll
    for (int mi = 0; mi < 4; ++mi)
#pragma unroll
      for (int ni = 0; ni < 2; ++ni) acc[mi][ni] = f32x16{};
    if (n0 < 2048) {
      gemm_main<4, 2, 2, 4, true>(XB + (size_t)m0 * DM, DM, WIN + (size_t)n0 * DM, DM, DM / 64, smem, acc);
      const int b = m0 >> 12, l0 = (m0 & 4095) + wm * 128 + r32;
#pragma unroll
      for (int mi = 0; mi < 4; ++mi) {
        const float rs = rstd[m0 + wm * 128 + mi * 32 + r32];
#pragma unroll
        for (int ni = 0; ni < 2; ++ni) {
          bfr* dst = HYT + ((size_t)(b * 2048 + n0 + wn * 64 + ni * 32 + 4 * hi)) * L + l0 + mi * 32;
#pragma unroll
          for (int r = 0; r < 16; ++r) dst[(size_t)((r & 3) + 8 * (r >> 2)) * L] = f2bf(acc[mi][ni][r] * rs);
        }
      }
    } else {
      gemm_main<4, 2, 2, 4, false>(XB + (size_t)m0 * DM, DM, WIN + (size_t)n0 * DM, DM, DM / 64, smem, acc);
#pragma unroll
      for (int mi = 0; mi < 4; ++mi) {
#pragma unroll
        for (int ni = 0; ni < 2; ++ni) {
          const int nc = n0 + wn * 64 + ni * 32;
          const int mrow = m0 + wm * 128 + mi * 32 + 4 * hi;
          if (nc < 3232) {
            bfr* dst = P2 + (size_t)mrow * P2W + (nc - 2048) + r32;
#pragma unroll
            for (int r = 0; r < 16; ++r) { const int ro = (r & 3) + 8 * (r >> 2); dst[(size_t)ro * P2W] = f2bf(acc[mi][ni][r] * rstd[mrow + ro]); }
          } else if (nc < INC) {
            bfr* dst = GATES + (size_t)mrow * 2048 + (nc - 3232) + r32;
            const float bg = p.b_gate[nc - 3232 + r32];
#pragma unroll
            for (int r = 0; r < 16; ++r) { const int ro = (r & 3) + 8 * (r >> 2); dst[(size_t)ro * 2048] = f2bf(sigmoidf_(acc[mi][ni][r] * rstd[mrow + ro] + bg)); }
          }
        }
      }
    }
  }
}

using u32x2 = __attribute__((ext_vector_type(2))) unsigned;
__device__ __forceinline__ float swap_add(float x) {
  auto rr = __builtin_amdgcn_permlane32_swap(__float_as_uint(x), __float_as_uint(x), false, false);
  return __uint_as_float(rr[0]) + __uint_as_float(rr[1]);
}
template <int N8> __device__ __forceinline__ float sumsq_bf16(const bfr* __restrict__ p) {
  float s = 0.f;
#pragma unroll 4
  for (int i = 0; i < N8; ++i) {
    const u32x4 v = *(const u32x4*)(p + 8 * i);
#pragma unroll
    for (int j = 0; j < 4; ++j) { const float a = __uint_as_float(v[j] << 16), b = __uint_as_float(v[j] & 0xffff0000u); s += a * a + b * b; }
  }
  return s;
}
__device__ void phase_qkv(const Params& p, char* smem) {
  char* ws = p.ws;
  const bfr* P2 = (const bfr*)(ws + OFF_P2); const float* rope = (const float*)(ws + OFF_ROPE);
  const bfr* WUQ = (const bfr*)(ws + OFF_WUQ); const bfr* WUKV = (const bfr*)(ws + OFF_WUKV);
  bfr* Q = (bfr*)(ws + OFF_Q); bfr* K = (bfr*)(ws + OFF_K); bfr* V = (bfr*)(ws + OFF_V);
  const int tid_ = otid(), wid = tid_ >> 6, lane = tid_ & 63, r32 = lane & 31, hi = lane >> 5;
  constexpr int NQ = (NTOK / 128) * 2, NKV = (NTOK / 256) * 4;
  for (int it = blockIdx.x; it < NQ; it += gridDim.x) {
    {
      const int tn = it & 1, tm = it >> 1, m0 = tm * 128, wm = wid >> 2, wn = wid & 3, head = tn * 4 + wn;
      f32x16 acc[2][3];
#pragma unroll
      for (int mi = 0; mi < 2; ++mi)
#pragma unroll
        for (int ni = 0; ni < 3; ++ni) acc[mi][ni] = f32x16{};
      float rsv[2];
#pragma unroll
      for (int mi = 0; mi < 2; ++mi)
        rsv[mi] = rsqrtf(swap_add(sumsq_bf16<24>(P2 + (size_t)(m0 + wm * 64 + mi * 32 + r32) * P2W + P2_CQ + hi * 192)) / (float)QL + EPS);
      SBAR();
      gemm_main<2, 3, 2, 4, true>(P2 + (size_t)m0 * P2W + P2_CQ, P2W, WUQ + (size_t)tn * 384 * QL, QL, QL / 64, smem, acc);
#pragma unroll
      for (int mi = 0; mi < 2; ++mi) {
        SBAR();
        int hi4 = 4 * hi; asm volatile("" : "+v"(hi4));
        const int tok = m0 + wm * 64 + mi * 32 + r32, b = tok >> 12, l = tok & 4095;
        const float rs = rsv[mi];
        float s2 = 0.f;
#pragma unroll
        for (int ni = 0; ni < 3; ++ni)
#pragma unroll
          for (int r = 0; r < 16; ++r) { const float v = acc[mi][ni][r] * rs; acc[mi][ni][r] = v; s2 += v * v; }
        const float r2 = rsqrtf(swap_add(s2) / (float)QKD + EPS);
#pragma unroll
        for (int ni = 0; ni < 3; ++ni)
#pragma unroll
          for (int g = 0; g < 4; ++g) {
            const float4 gg = *(const float4*)(p.g_qn + ni * 32 + 8 * g + hi4);
            acc[mi][ni][4 * g] *= r2 * gg.x; acc[mi][ni][4 * g + 1] *= r2 * gg.y; acc[mi][ni][4 * g + 2] *= r2 * gg.z; acc[mi][ni][4 * g + 3] *= r2 * gg.w;
          }
#pragma unroll
        for (int r = 0; r < 8; ++r) {
          const float2 cs = *(const float2*)(rope + (l * 16 + crow(r, hi)) * 2);
          const float t1 = acc[mi][2][r], t2 = acc[mi][2][r + 8];
          acc[mi][2][r] = t1 * cs.x - t2 * cs.y; acc[mi][2][r + 8] = t1 * cs.y + t2 * cs.x;
        }
        bfr* q = Q + ((size_t)((b * NH + head) * L + l)) * QKD + 4 * hi;
#pragma unroll
        for (int ni = 0; ni < 3; ++ni)
#pragma unroll
          for (int g = 0; g < 4; ++g) {
            u32x2 w = {cvtpk(acc[mi][ni][4 * g], acc[mi][ni][4 * g + 1]), cvtpk(acc[mi][ni][4 * g + 2], acc[mi][ni][4 * g + 3])};
            *(u32x2*)(q + ni * 32 + 8 * g) = w;
          }
      }
    }
  }
  for (int i2 = blockIdx.x; i2 < NKV; i2 += gridDim.x) {
    {
      const int tn = i2 & 3, tm = i2 >> 2, m0 = tm * 256, wm = wid >> 1, wn = wid & 1, head = tn * 2 + wn;
      f32x16 acc[2][4];
#pragma unroll
      for (int mi = 0; mi < 2; ++mi)
#pragma unroll
        for (int ni = 0; ni < 4; ++ni) acc[mi][ni] = f32x16{};
      float rsv[2];
#pragma unroll
      for (int mi = 0; mi < 2; ++mi)
        rsv[mi] = rsqrtf(swap_add(sumsq_bf16<16>(P2 + (size_t)(m0 + wm * 64 + mi * 32 + r32) * P2W + P2_CKV + hi * 128)) / (float)KVL + EPS);
      SBAR();
      gemm_main<2, 4, 4, 2, true>(P2 + (size_t)m0 * P2W + P2_CKV, P2W, WUKV + (size_t)tn * 256 * KVL, KVL, KVL / 64, smem, acc);
#pragma unroll
      for (int mi = 0; mi < 2; ++mi) {
        SBAR();
        int hi4 = 4 * hi; asm volatile("" : "+v"(hi4));
        const int tok = m0 + wm * 64 + mi * 32 + r32, b = tok >> 12, l = tok & 4095;
        const bfr* prow = P2 + (size_t)tok * P2W;
        const float rs = rsv[mi];
        float kr[16];
#pragma unroll
        for (int g = 0; g < 4; ++g) {
          const u32x2 w = *(const u32x2*)(prow + P2_KR + 8 * g + 4 * hi);
          kr[4 * g] = __uint_as_float(w[0] << 16); kr[4 * g + 1] = __uint_as_float(w[0] & 0xffff0000u);
          kr[4 * g + 2] = __uint_as_float(w[1] << 16); kr[4 * g + 3] = __uint_as_float(w[1] & 0xffff0000u);
        }
        float s2 = 0.f;
#pragma unroll
        for (int ni = 0; ni < 4; ++ni)
#pragma unroll
          for (int r = 0; r < 16; ++r) { const float v = acc[mi][ni][r] * rs; acc[mi][ni][r] = v; if (ni < 2) s2 += v * v; }
#pragma unroll
        for (int r = 0; r < 16; ++r) s2 += kr[r] * kr[r];
        const float r2 = rsqrtf(swap_add(s2) / (float)QKD + EPS);
#pragma unroll
        for (int ni = 0; ni < 2; ++ni)
#pragma unroll
          for (int g = 0; g < 4; ++g) {
            const float4 gg = *(const float4*)(p.g_kn + ni * 32 + 8 * g + hi4);
            acc[mi][ni][4 * g] *= r2 * gg.x; acc[mi][ni][4 * g + 1] *= r2 * gg.y; acc[mi][ni][4 * g + 2] *= r2 * gg.z; acc[mi][ni][4 * g + 3] *= r2 * gg.w;
          }
#pragma unroll
        for (int g = 0; g < 4; ++g) {
          const float4 gg = *(const float4*)(p.g_kn + 64 + 8 * g + hi4);
          kr[4 * g] *= r2 * gg.x; kr[4 * g + 1] *= r2 * gg.y; kr[4 * g + 2] *= r2 * gg.z; kr[4 * g + 3] *= r2 * gg.w;
        }
#pragma unroll
        for (int r = 0; r < 8; ++r) {
          const float2 cs = *(const float2*)(rope + (l * 16 + crow(r, hi)) * 2);
          const float t1 = kr[r], t2 = kr[r + 8];
          kr[r] = t1 * cs.x - t2 * cs.y; kr[r + 8] = t1 * cs.y + t2 * cs.x;
        }
        bfr* kp = K + ((size_t)((b * NH + head) * L + l)) * KPAD + 4 * hi;
#pragma unroll
        for (int ni = 0; ni < 2; ++ni)
#pragma unroll
          for (int g = 0; g < 4; ++g) {
            u32x2 w = {cvtpk(acc[mi][ni][4 * g], acc[mi][ni][4 * g + 1]), cvtpk(acc[mi][ni][4 * g + 2], acc[mi][ni][4 * g + 3])};
            *(u32x2*)(kp + ni * 32 + 8 * g) = w;
          }
#pragma unroll
        for (int g = 0; g < 4; ++g) {
          u32x2 w = {cvtpk(kr[4 * g], kr[4 * g + 1]), cvtpk(kr[4 * g + 2], kr[4 * g + 3])};
          *(u32x2*)(kp + 64 + 8 * g) = w;
        }
        bfr* vp = V + ((size_t)((b * NH + head) * L + l)) * VD + 4 * hi;
#pragma unroll
        for (int ni = 2; ni < 4; ++ni)
#pragma unroll
          for (int g = 0; g < 4; ++g) {
            u32x2 w = {cvtpk(acc[mi][ni][4 * g], acc[mi][ni][4 * g + 1]), cvtpk(acc[mi][ni][4 * g + 2], acc[mi][ni][4 * g + 3])};
            *(u32x2*)(vp + (ni - 2) * 32 + 8 * g) = w;
          }
      }
    }
  }
}

constexpr int AT_SHM_V = 64 * VD * 2, AT_SHM_K = 64 * KPAD * 2;
constexpr float AT_SCALE = 0.10206207261596575f;
constexpr float AT_THR = 8.f;
#define KSWZ(row, colB) ((row) * 256 + ((colB) ^ (((row) & 7) << 4)))
__device__ __forceinline__ void partialSM(f32x16& p0, f32x16& p1, float& m_reg, float& mn, float& alpha) {
  constexpr float C = AT_SCALE * 1.4426950408889634f;
  float pmax = p0[0];
#pragma unroll
  for (int r = 1; r < 16; ++r) pmax = fmaxf(pmax, p0[r]);
#pragma unroll
  for (int r = 0; r < 16; ++r) pmax = fmaxf(pmax, p1[r]);
  { auto rr = __builtin_amdgcn_permlane32_swap(__float_as_uint(pmax), __float_as_uint(pmax), false, false);
    pmax = fmaxf(__uint_as_float(rr[0]), __uint_as_float(rr[1])); }
  if (__builtin_expect(__all(pmax - m_reg <= AT_THR / AT_SCALE), 1)) { mn = m_reg; alpha = 1.f; }
  else { mn = fmaxf(m_reg, pmax); alpha = __builtin_amdgcn_exp2f((m_reg - mn) * C); m_reg = mn; }
  float mnC = -mn * C;
#pragma unroll
  for (int r = 0; r < 16; ++r) p0[r] = fmaf(p0[r], C, mnC);
#pragma unroll
  for (int r = 0; r < 16; ++r) p1[r] = fmaf(p1[r], C, mnC);
#pragma unroll
  for (int r = 0; r < 16; ++r) p0[r] = __builtin_amdgcn_exp2f(p0[r]);
}
__device__ __forceinline__ void finishSM(f32x16& p0, f32x16& p1, float alpha, float& l_reg, bf16x8& pa0, bf16x8& pa1, bf16x8& pa2, bf16x8& pa3) {
#pragma unroll
  for (int r = 0; r < 16; ++r) p1[r] = __builtin_amdgcn_exp2f(p1[r]);
  float ps = 0;
#pragma unroll
  for (int r = 0; r < 16; ++r) ps += p0[r];
#pragma unroll
  for (int r = 0; r < 16; ++r) ps += p1[r];
  { auto rr = __builtin_amdgcn_permlane32_swap(__float_as_uint(ps), __float_as_uint(ps), false, false);
    ps = __uint_as_float(rr[0]) + __uint_as_float(rr[1]); }
  l_reg = l_reg * alpha + ps;
#define PK4(P, BASE, OUT) do { unsigned a0 = cvtpk(P[BASE + 0], P[BASE + 1]), a1 = cvtpk(P[BASE + 2], P[BASE + 3]);   \
    unsigned b0 = cvtpk(P[BASE + 4], P[BASE + 5]), b1 = cvtpk(P[BASE + 6], P[BASE + 7]);                              \
    auto r0 = __builtin_amdgcn_permlane32_swap(a0, b0, false, false); auto r1 = __builtin_amdgcn_permlane32_swap(a1, b1, false, false); \
    u32x4 w = {r0[0], r1[0], r0[1], r1[1]}; OUT = *reinterpret_cast<bf16x8*>(&w); } while (0)
  PK4(p0, 0, pa0); PK4(p0, 8, pa1); PK4(p1, 0, pa2); PK4(p1, 8, pa3);
#undef PK4
}
__device__ __forceinline__ void qkt(f32x16& p0, f32x16& p1, const char* Ks, const bf16x8* qr, int r32, int hi) {
  p0 = f32x16{}; p1 = f32x16{};
#pragma unroll
  for (int d0 = 0; d0 < 6; ++d0) { int cb = (d0 * 16 + hi * 8) * 2;
    bf16x8 b0 = *reinterpret_cast<const bf16x8*>(Ks + KSWZ(r32, cb));
    bf16x8 b1 = *reinterpret_cast<const bf16x8*>(Ks + KSWZ(32 + r32, cb));
    p0 = __builtin_amdgcn_mfma_f32_32x32x16_bf16(b0, qr[d0], p0, 0, 0, 0);
    p1 = __builtin_amdgcn_mfma_f32_32x32x16_bf16(b1, qr[d0], p1, 0, 0, 0); }
}
__device__ __forceinline__ int v_st(int k, int c) { const int kk = (k & ~0xC) | ((k & 4) << 1) | ((k & 8) >> 1); return ((kk >> 3) * 2 + (c >> 5)) * 512 + ((kk & 7) * 32 + (c & 31)) * 2; }
__device__ __forceinline__ int v_rd_base(int lane) { return ((lane & 3) << 3) | (((lane >> 2) & 3) << 6) | (((lane >> 4) & 1) << 5) | (((lane >> 5) & 1) << 8); }
constexpr int v_rd_off(int d0, int ks, int half) { return d0 * 512 + ks * 2048 + half * 1024; }
template <int OFF> __device__ __forceinline__ s16x4 tr_read(int vb) {
  s16x4 r; asm volatile("ds_read_b64_tr_b16 %0, %1 offset:%2" : "=&v"(r) : "v"(vb), "i"(OFF) : "memory"); return r;
}
template <int D0> __device__ __forceinline__ void pv_one(f32x16& od, int vb, bf16x8 pa0, bf16x8 pa1, bf16x8 pa2, bf16x8 pa3) {
  const s16x4 l0 = tr_read<v_rd_off(D0, 0, 0)>(vb), h0 = tr_read<v_rd_off(D0, 0, 1)>(vb), l1 = tr_read<v_rd_off(D0, 1, 0)>(vb), h1 = tr_read<v_rd_off(D0, 1, 1)>(vb);
  const s16x4 l2 = tr_read<v_rd_off(D0, 2, 0)>(vb), h2 = tr_read<v_rd_off(D0, 2, 1)>(vb), l3 = tr_read<v_rd_off(D0, 3, 0)>(vb), h3 = tr_read<v_rd_off(D0, 3, 1)>(vb);
  asm volatile("s_waitcnt lgkmcnt(0)" ::: "memory"); SBAR();
#define PK(LL, HH) (bf16x8){LL[0], LL[1], LL[2], LL[3], HH[0], HH[1], HH[2], HH[3]}
  od = __builtin_amdgcn_mfma_f32_32x32x16_bf16(pa0, PK(l0, h0), od, 0, 0, 0);
  od = __builtin_amdgcn_mfma_f32_32x32x16_bf16(pa1, PK(l1, h1), od, 0, 0, 0);
  od = __builtin_amdgcn_mfma_f32_32x32x16_bf16(pa2, PK(l2, h2), od, 0, 0, 0);
  od = __builtin_amdgcn_mfma_f32_32x32x16_bf16(pa3, PK(l3, h3), od, 0, 0, 0);
#undef PK
}
__device__ __forceinline__ void pv_d0(f32x16* o, int vb, bf16x8 pa0, bf16x8 pa1, bf16x8 pa2, bf16x8 pa3) {
  pv_one<0>(o[0], vb, pa0, pa1, pa2, pa3); pv_one<1>(o[1], vb, pa0, pa1, pa2, pa3);
}
__device__ __forceinline__ void attn_body(const bfr* __restrict__ Qb, const bfr* __restrict__ Kh, const bfr* __restrict__ Vh,
                                          const bfr* __restrict__ za, bfr* __restrict__ op, char* lds) {
  const int tid = otid(), wid = tid >> 6, lane = tid & 63, r32 = lane & 31, hi = lane >> 5;
  char* V_lds = lds; char* K_lds = lds + 2 * AT_SHM_V;
  float* wsm = (float*)(lds + 2 * AT_SHM_V + 2 * AT_SHM_K) + wid * 64; float* li_l = wsm; float* al_l = wsm + 32;
  float m_reg = -1e30f, l_reg = 0; f32x16 o[2] = {}; bf16x8 qr[6];
  const bfr* Qw = Qb + (long)(wid * 32 + r32) * QKD + hi * 8;
#pragma unroll
  for (int d0 = 0; d0 < 6; ++d0) qr[d0] = *reinterpret_cast<const bf16x8*>(Qw + d0 * 16);
  const int sr = tid >> 4, sc = (tid & 15) * 8, vr = tid >> 3, vc = (tid & 7) * 8, vst0 = v_st(vr, vc);
  const int vb0 = (int)(uintptr_t)V_lds + v_rd_base(lane);
  struct { bf16x8 vs0, ks0, ks1; } sr_[2];
#define SLOAD(i, k0) do { sr_[i].vs0 = *reinterpret_cast<const bf16x8*>(&Vh[(long)((k0) + vr) * VD + vc]); \
    sr_[i].ks0 = *reinterpret_cast<const bf16x8*>(&Kh[(long)((k0) + sr) * KPAD + sc]); sr_[i].ks1 = *reinterpret_cast<const bf16x8*>(&Kh[(long)((k0) + 32 + sr) * KPAD + sc]); } while (0)
#define SWRITE(b, i) do { *(bf16x8*)(V_lds + (b) * AT_SHM_V + vst0) = sr_[i].vs0; int kc = sc * 2;               \
    *(bf16x8*)(K_lds + (b) * AT_SHM_K + KSWZ(sr, kc)) = sr_[i].ks0;                       \
    *(bf16x8*)(K_lds + (b) * AT_SHM_K + KSWZ(32 + sr, kc)) = sr_[i].ks1; } while (0)
#define SWAIT() asm volatile("s_waitcnt vmcnt(3)" ::: "memory")
#define RESC(a) do { if (__any((a) < 1.f)) { if (hi == 0) al_l[r32] = (a); asm volatile("s_waitcnt lgkmcnt(0)" ::: "memory"); \
    for (int d = 0; d < 2; ++d) for (int r = 0; r < 16; ++r) o[d][r] *= al_l[crow(r, hi)]; } } while (0)
  f32x16 pA0, pA1, pB0, pB1; float mnA, mnB, alA, alB; bf16x8 pa0, pa1, pa2, pa3; constexpr int NTL = L / 64;
  constexpr int SE = 0, SO = 1;
  SLOAD(SE, 0); asm volatile("s_waitcnt vmcnt(0)" ::: "memory"); SWRITE(0, SE); __syncthreads();
  qkt(pA0, pA1, K_lds, qr, r32, hi); partialSM(pA0, pA1, m_reg, mnA, alA);
  SLOAD(SO, 64); SLOAD(SE, 128);
  SWAIT(); SWRITE(1, SO); __syncthreads();
  for (int j = 1; j + 1 < NTL; j += 2) {
    SBAR(); qkt(pB0, pB1, K_lds + AT_SHM_K, qr, r32, hi);
    finishSM(pA0, pA1, alA, l_reg, pa0, pa1, pa2, pa3); SBAR();
    SLOAD(SO, (j + 2) * 64); SBAR();
    pv_d0(o, vb0, pa0, pa1, pa2, pa3); partialSM(pB0, pB1, m_reg, mnB, alB);
    __syncthreads(); SWAIT(); SWRITE(0, SE);
    RESC(alB); __syncthreads();
    SBAR(); qkt(pA0, pA1, K_lds, qr, r32, hi);
    finishSM(pB0, pB1, alB, l_reg, pa0, pa1, pa2, pa3); SBAR();
    if (j + 3 < NTL) SLOAD(SE, (j + 3) * 64); SBAR();
    pv_d0(o, vb0 + AT_SHM_V, pa0, pa1, pa2, pa3); partialSM(pA0, pA1, m_reg, mnA, alA);
    __syncthreads(); SWAIT(); SWRITE(1, SO);
    RESC(alA); __syncthreads();
  }
  SBAR(); qkt(pB0, pB1, K_lds + AT_SHM_K, qr, r32, hi);
  finishSM(pA0, pA1, alA, l_reg, pa0, pa1, pa2, pa3); SBAR();
  pv_d0(o, vb0, pa0, pa1, pa2, pa3); partialSM(pB0, pB1, m_reg, mnB, alB);
  __syncthreads(); RESC(alB);
  finishSM(pB0, pB1, alB, l_reg, pa0, pa1, pa2, pa3); SBAR();
  pv_d0(o, vb0 + AT_SHM_V, pa0, pa1, pa2, pa3);
  if (hi == 0) li_l[r32] = l_reg; asm volatile("s_waitcnt lgkmcnt(0)" ::: "memory");
  float rli[16];
#pragma unroll
  for (int r = 0; r < 16; ++r) rli[r] = __builtin_amdgcn_rcpf(li_l[crow(r, hi)]);
  int row0 = wid * 32 + 4 * hi; asm volatile("" : "+v"(row0));
  const bfr* zr = za + row0 * P2W + r32; bfr* orp = op + row0 * HY + r32;
#pragma unroll
  for (int r = 0; r < 16; ++r) { const int ro = (r & 3) + 8 * (r >> 2);
#pragma unroll
    for (int d0 = 0; d0 < 2; ++d0) {
      const float z = bf2f(zr[ro * P2W + d0 * 32]);
      orp[ro * HY + d0 * 32] = f2bf(o[d0][r] * rli[r] * siluf_(z)); } }
#undef SLOAD
#undef SWRITE
#undef SWAIT
#undef RESC
}
__device__ void phase_attn(const Params& p, char* smem) {
  char* ws = p.ws;
  const bfr* Q = (const bfr*)(ws + OFF_Q); const bfr* K = (const bfr*)(ws + OFF_K); const bfr* V = (const bfr*)(ws + OFF_V);
  const bfr* P2 = (const bfr*)(ws + OFF_P2); bfr* AAT = (bfr*)(ws + OFF_AAT);
  constexpr int NQB = L / 256, NIT = NQB * NB * NH;
  for (int it = blockIdx.x; it < NIT; it += gridDim.x) {
    const int bh = it / NQB, qb = it % NQB, b = bh >> 3, h = bh & 7;
    const size_t tok0 = (size_t)b * L + qb * 256;
    __syncthreads();
    attn_body(Q + ((size_t)bh * L + qb * 256) * QKD, K + (size_t)bh * L * KPAD, V + (size_t)bh * L * VD,
              P2 + tok0 * P2W + P2_ZA + h * VD, AAT + tok0 * HY + h * VD, smem);
  }
}

__device__ __forceinline__ float2 cmul(float2 a, float2 b) { return make_float2(a.x * b.x - a.y * b.y, a.x * b.y + a.y * b.x); }
__device__ __forceinline__ float2 cmulc(float2 a, float2 b) { return make_float2(a.x * b.x + a.y * b.y, a.y * b.x - a.x * b.y); }
__device__ __forceinline__ constexpr int br4(int r) { return ((r & 1) << 3) | ((r & 2) << 1) | ((r & 4) >> 1) | ((r & 8) >> 3); }
template <bool INV> __device__ __forceinline__ float2 tw16(float2 v, int j) {
  const float C1 = 0.92387953251128674f, S1 = 0.38268343236508977f, R = 0.70710678118654752f;
  float c, s;
  switch (j) { case 0: return v;
    case 1: c = C1; s = S1; break; case 2: c = R; s = R; break; case 3: c = S1; s = C1; break;
    case 4: return INV ? make_float2(-v.y, v.x) : make_float2(v.y, -v.x);
    case 5: c = -S1; s = C1; break; case 6: c = -R; s = R; break; default: c = -C1; s = S1; break; }
  if (INV) s = -s;
  return make_float2(v.x * c + v.y * s, v.y * c - v.x * s);
}
__device__ __forceinline__ void fft16_dif(float2 (&a)[16]) {
#pragma unroll
  for (int s = 0; s < 4; ++s) {
    const int half = 8 >> s;
#pragma unroll
    for (int start = 0; start < 16; start += 2 * half) {
#pragma unroll
      for (int j = 0; j < half; ++j) {
        float2 u = a[start + j], v = a[start + j + half];
        a[start + j] = make_float2(u.x + v.x, u.y + v.y);
        a[start + j + half] = tw16<false>(make_float2(u.x - v.x, u.y - v.y), j * (8 / half));
      }
    }
  }
}
__device__ __forceinline__ void ifft16_dit(float2 (&a)[16]) {
#pragma unroll
  for (int s = 3; s >= 0; --s) {
    const int half = 8 >> s;
#pragma unroll
    for (int start = 0; start < 16; start += 2 * half) {
#pragma unroll
      for (int j = 0; j < half; ++j) {
        float2 pp = a[start + j], q = tw16<true>(a[start + j + half], j * (8 / half));
        a[start + j] = make_float2(pp.x + q.x, pp.y + q.y);
        a[start + j + half] = make_float2(pp.x - q.x, pp.y - q.y);
      }
    }
  }
}
__device__ __forceinline__ void hy_fwd(float2* lds, const float2* __restrict__ TW1, const float2* __restrict__ TW2, float2 (&a)[16]) {
  const int tid = threadIdx.x, m = tid & 255, k1 = m >> 4, lo = m & 15;
  float2* base = lds + (tid >> 8) * FLD;
#pragma unroll
  for (int n = 0; n < 16; ++n) a[n] = base[n * 272 + m];
  fft16_dif(a);
#pragma unroll
  for (int r = 0; r < 16; ++r) { const int k = br4(r); base[k * 272 + m] = cmul(a[r], TW1[k * 256 + m]); }
  __syncthreads();
#pragma unroll
  for (int n = 0; n < 16; ++n) a[n] = base[k1 * 272 + n * 16 + lo];
  fft16_dif(a);
  __syncthreads();
#pragma unroll
  for (int r = 0; r < 16; ++r) { const int k = br4(r); base[k1 * 272 + lo * 17 + k] = cmul(a[r], TW2[k * 16 + lo]); }
  __syncthreads();
#pragma unroll
  for (int n = 0; n < 16; ++n) a[n] = base[k1 * 272 + n * 17 + lo];
  fft16_dif(a);
}
__device__ __forceinline__ void hy_inv(float2* lds, const float2* __restrict__ TW1, const float2* __restrict__ TW2, float2 (&a)[16]) {
  const int tid = threadIdx.x, m = tid & 255, k1 = m >> 4, lo = m & 15;
  float2* base = lds + (tid >> 8) * FLD;
  ifft16_dit(a);
#pragma unroll
  for (int n = 0; n < 16; ++n) base[k1 * 272 + n * 17 + lo] = cmulc(a[n], TW2[n * 16 + lo]);
  __syncthreads();
#pragma unroll
  for (int r = 0; r < 16; ++r) a[r] = base[k1 * 272 + lo * 17 + br4(r)];
  ifft16_dit(a);
  __syncthreads();
#pragma unroll
  for (int n = 0; n < 16; ++n) base[k1 * 272 + n * 16 + lo] = cmulc(a[n], TW1[k1 * 256 + 16 * n + lo]);
  __syncthreads();
#pragma unroll
  for (int r = 0; r < 16; ++r) a[r] = base[br4(r) * 272 + m];
  ifft16_dit(a);
#pragma unroll
  for (int n = 0; n < 16; ++n) base[n * 272 + m] = a[n];
  __syncthreads();
}

__device__ void phase_spectra(const Params& p, char* smem) {
  char* ws = p.ws;
  const float* KF = (const float*)(ws + OFF_KF); float2* KS = (float2*)(ws + OFF_KS);
  const float2* TW0 = (const float2*)(ws + OFF_TW0); const float2* TW1 = (const float2*)(ws + OFF_TW1); const float2* TW2 = (const float2*)(ws + OFF_TW2);
  float2* lds = (float2*)smem;
  const int tid = threadIdx.x;
  for (int it = blockIdx.x; it < 2 * HY; it += gridDim.x) {
    const float* kf = KF + (size_t)it * 2 * L;
    __syncthreads();
#pragma unroll
    for (int j = 0; j < 8; ++j) {
      const int i = tid + NT * j, pos = (i >> 8) * 272 + (i & 255);
      const float lo = kf[i], hi = kf[L + (L - 1 - i)];
      lds[pos] = make_float2(lo + hi, 0.f);
      const float2 w = TW0[i]; const float d = lo - hi;
      lds[FLD + pos] = make_float2(d * w.x, d * w.y);
    }
    __syncthreads();
    float2 a[16];
    hy_fwd(lds, TW1, TW2, a);
    float2* ks = KS + (size_t)it * 16 * NT;
#pragma unroll
    for (int r = 0; r < 16; ++r) ks[r * NT + tid] = make_float2(a[r].x * (1.f / 8192.f), a[r].y * (1.f / 8192.f));
  }
}

__device__ __forceinline__ void sconv8(const bfr* __restrict__ seq, int tid, float w0, float w1, float w2, float bb, float (&u)[8]) {
  const bfr* s = seq + 8 * tid;
  const uint4 raw = *(const uint4*)s;
  float in[10];
  in[0] = tid > 0 ? bf2f(s[-1]) : 0.f; in[9] = tid < NT - 1 ? bf2f(s[8]) : 0.f;
  in[1] = __uint_as_float(raw.x << 16); in[2] = __uint_as_float(raw.x & 0xffff0000u);
  in[3] = __uint_as_float(raw.y << 16); in[4] = __uint_as_float(raw.y & 0xffff0000u);
  in[5] = __uint_as_float(raw.z << 16); in[6] = __uint_as_float(raw.z & 0xffff0000u);
  in[7] = __uint_as_float(raw.w << 16); in[8] = __uint_as_float(raw.w & 0xffff0000u);
#pragma unroll
  for (int j = 0; j < 8; ++j) u[j] = w0 * in[j] + w1 * in[j + 1] + w2 * in[j + 2] + bb;
}
__device__ __forceinline__ void ld8bf(const bfr* __restrict__ seq, int tid, float (&u)[8]) {
  const uint4 raw = *(const uint4*)(seq + 8 * tid);
  u[0] = __uint_as_float(raw.x << 16); u[1] = __uint_as_float(raw.x & 0xffff0000u);
  u[2] = __uint_as_float(raw.y << 16); u[3] = __uint_as_float(raw.y & 0xffff0000u);
  u[4] = __uint_as_float(raw.z << 16); u[5] = __uint_as_float(raw.z & 0xffff0000u);
  u[6] = __uint_as_float(raw.w << 16); u[7] = __uint_as_float(raw.w & 0xffff0000u);
}
__device__ __forceinline__ void hy_scatter(float2* lds, const float2* __restrict__ TW0, const float2 (&z)[8]) {
  const int tid = threadIdx.x, pos = (tid >> 5) * 272 + 8 * (tid & 31);
  const float4* tw = (const float4*)(TW0 + 8 * tid);
#pragma unroll
  for (int j = 0; j < 4; ++j) {
    const float4 w = tw[j];
    *(float4*)(lds + pos + 2 * j) = make_float4(z[2 * j].x, z[2 * j].y, z[2 * j + 1].x, z[2 * j + 1].y);
    const float2 o0 = cmul(z[2 * j], make_float2(w.x, w.y)), o1 = cmul(z[2 * j + 1], make_float2(w.z, w.w));
    *(float4*)(lds + FLD + pos + 2 * j) = make_float4(o0.x, o0.y, o1.x, o1.y);
  }
}
__device__ __forceinline__ void hy_gather(const float2* lds, const float2* __restrict__ TW0, float2 (&y)[8]) {
  const int tid = threadIdx.x, pos = (tid >> 5) * 272 + 8 * (tid & 31);
  const float4* tw = (const float4*)(TW0 + 8 * tid);
#pragma unroll
  for (int j = 0; j < 4; ++j) {
    const float4 w = tw[j];
    const float4 e = *(const float4*)(lds + pos + 2 * j), o = *(const float4*)(lds + FLD + pos + 2 * j);
    const float2 t0 = cmulc(make_float2(o.x, o.y), make_float2(w.x, w.y)), t1 = cmulc(make_float2(o.z, o.w), make_float2(w.z, w.w));
    y[2 * j] = make_float2(e.x + t0.x, e.y + t0.y); y[2 * j + 1] = make_float2(e.z + t1.x, e.w + t1.y);
  }
}
__device__ void phase_hyena(const Params& p, char* smem) {
  char* ws = p.ws;
  const bfr* HYT = (const bfr*)(ws + OFF_HYT); const float2* KS = (const float2*)(ws + OFF_KS); bfr* AHY = (bfr*)(ws + OFF_AHY);
  const float2* TW0 = (const float2*)(ws + OFF_TW0); const float2* TW1 = (const float2*)(ws + OFF_TW1); const float2* TW2 = (const float2*)(ws + OFF_TW2);
  float2* lds = (float2*)smem;
  const int tid = threadIdx.x;
  for (int n = 0;; ++n) {
    const int c = blockIdx.x + gridDim.x * (n >> 2), bp = n & 3;
    if (c >= HY) break;
    const int b0 = 2 * bp, b1 = b0 + 1;
    float2 zin[8];
    {
      float u0[8], u1[8];
      const float w0 = p.w_short[c], w1 = p.w_short[1536 + c], w2 = p.w_short[3072 + c], bb = p.b_short[c];
      sconv8(HYT + ((size_t)(b0 * 2048 + c)) * L, tid, w0, w1, w2, bb, u0);
      sconv8(HYT + ((size_t)(b1 * 2048 + c)) * L, tid, w0, w1, w2, bb, u1);
#pragma unroll
      for (int j = 0; j < 8; ++j) zin[j] = make_float2(u0[j], u1[j]);
      __syncthreads();
      hy_scatter(lds, TW0, zin);
      __syncthreads();
    }
#pragma unroll 1
    for (int o = 0; o < 2; ++o) {
      {
        float2 a[16];
        hy_fwd(lds, TW1, TW2, a);
        const float2* ks = KS + (size_t)(o * HY + c) * 16 * NT;
#pragma unroll
        for (int r = 0; r < 16; ++r) a[r] = cmul(a[r], ks[r * NT + tid]);
        hy_inv(lds, TW1, TW2, a);
      }
      __builtin_amdgcn_sched_barrier(0);
      float2 y[8];
      hy_gather(lds, TW0, y);
      const int chg = (o == 0 ? 512 : 1024) + c;
      const float w0 = p.w_short[chg], w1 = p.w_short[1536 + chg], w2 = p.w_short[3072 + chg], bb = p.b_short[chg];
      const float bias = p.hy_bias[o * HY + c];
      float g0[8], g1[8];
      sconv8(HYT + ((size_t)(b0 * 2048 + chg)) * L, tid, w0, w1, w2, bb, g0);
      sconv8(HYT + ((size_t)(b1 * 2048 + chg)) * L, tid, w0, w1, w2, bb, g1);
#pragma unroll
      for (int j = 0; j < 8; ++j) zin[j] = make_float2(g0[j] * (y[j].x + bias * zin[j].x), g1[j] * (y[j].y + bias * zin[j].y));
      __syncthreads();
      if (o == 0) {
        hy_scatter(lds, TW0, zin);
        __syncthreads();
      } else {
        float z0[8], z1[8];
        ld8bf(HYT + ((size_t)(b0 * 2048 + 1536 + c)) * L, tid, z0);
        ld8bf(HYT + ((size_t)(b1 * 2048 + 1536 + c)) * L, tid, z1);
#pragma unroll
        for (int j = 0; j < 8; ++j) {
          const int i = 8 * tid + j;
          AHY[((size_t)(b0 * L + i)) * HY + c] = f2bf(zin[j].x * siluf_(z0[j]));
          AHY[((size_t)(b1 * L + i)) * HY + c] = f2bf(zin[j].y * siluf_(z1[j]));
        }
      }
    }
  }
}

__device__ void phase_out1(const Params& p, char* smem) {
  char* ws = p.ws;
  const bfr* AHY = (const bfr*)(ws + OFF_AHY); const bfr* AAT = (const bfr*)(ws + OFF_AAT); const bfr* WHY = (const bfr*)(ws + OFF_WHY); const bfr* WAT = (const bfr*)(ws + OFF_WAT);
  const bfr* GATES = (const bfr*)p.out; bfr* MRG = (bfr*)(ws + OFF_MRG);
  const int tid_ = otid(), wid = tid_ >> 6, lane = tid_ & 63, r32 = lane & 31, hi = lane >> 5, wm = wid >> 2, wn = wid & 3;
  constexpr int NTN = DM / 128, NTM = NTOK / 256;
  for (int it = blockIdx.x; it < NTN * NTM; it += gridDim.x) {
    const int tn = it % NTN, tm = it / NTN, m0 = tm * 256, n0 = tn * 128;
    f32x16 a1[4][1], a2[4][1];
#pragma unroll
    for (int mi = 0; mi < 4; ++mi) { a1[mi][0] = f32x16{}; a2[mi][0] = f32x16{}; }
    gemm_main<4, 1, 2, 4, false>(AHY + (size_t)m0 * HY, HY, WHY + (size_t)n0 * HY, HY, HY / 64, smem, a1);
    gemm_main<4, 1, 2, 4, false>(AAT + (size_t)m0 * HY, HY, WAT + (size_t)n0 * HY, HY, HY / 64, smem, a2);
    const int nc = n0 + wn * 32 + r32;
#pragma unroll
    for (int mi = 0; mi < 4; ++mi) {
      const int mrow = m0 + wm * 128 + mi * 32 + 4 * hi;
#pragma unroll
      for (int r = 0; r < 16; ++r) {
        const size_t row = mrow + (r & 3) + 8 * (r >> 2);
        const float gh = bf2f(GATES[row * 2048 + nc]), ga = bf2f(GATES[row * 2048 + 1024 + nc]);
        MRG[row * DM + nc] = f2bf(gh * a1[mi][0][r] + ga * a2[mi][0][r]);
      }
    }
  }
}
__device__ void phase_out2(const Params& p, char* smem) {
  char* ws = p.ws;
  const bfr* MRG = (const bfr*)(ws + OFF_MRG); const bfr* WOUT = (const bfr*)(ws + OFF_WOUT);
  const int tid_ = otid(), wid = tid_ >> 6, lane = tid_ & 63, r32 = lane & 31, hi = lane >> 5, wm = wid >> 2, wn = wid & 3;
  constexpr int NTN = DM / 256, NTM = NTOK / 256;
  for (int it = blockIdx.x; it < NTN * NTM; it += gridDim.x) {
    const int tn = it % NTN, tm = it / NTN, m0 = tm * 256, n0 = tn * 256;
    f32x16 acc[4][2];
#pragma unroll
    for (int mi = 0; mi < 4; ++mi)
#pragma unroll
      for (int ni = 0; ni < 2; ++ni) acc[mi][ni] = f32x16{};
    gemm_main<4, 2, 2, 4, false>(MRG + (size_t)m0 * DM, DM, WOUT + (size_t)n0 * DM, DM, DM / 64, smem, acc);
#pragma unroll
    for (int mi = 0; mi < 4; ++mi)
#pragma unroll
      for (int ni = 0; ni < 2; ++ni) {
        const size_t off = (size_t)(m0 + wm * 128 + mi * 32 + 4 * hi) * DM + n0 + wn * 64 + ni * 32 + r32;
#pragma unroll
        for (int r = 0; r < 16; ++r) { const size_t o2 = off + (size_t)((r & 3) + 8 * (r >> 2)) * DM; p.out[o2] = p.x[o2] + acc[mi][ni][r]; }
      }
  }
}

__global__ __launch_bounds__(NT, 1) void fwd_megakernel(Params p) {
  extern __shared__ __attribute__((aligned(16))) char smem[];
  cg::grid_group grid = cg::this_grid();
#define REP(n, stmt) { int nrep_ = (DUP == (n) ? 2 : 1); asm volatile("" : "+s"(nrep_)); _Pragma("unroll 1") for (int rep_ = 0; rep_ < nrep_; ++rep_) { stmt; } }
  volatile LAS unsigned* xst = (volatile LAS unsigned*)(smem + LDS_PHASE);
  if (threadIdx.x == 0) { xst[0] = 0u; xst[1] = 0u; }
  __syncthreads();
  XcdBarrier xb = xcd_barrier_post((unsigned*)(p.ws + OFF_BAR), xst);
  REP(1, phase0(p, smem));
  grid.sync();
  phase_filt_k(p);
  REP(2, phase_inproj(p, smem));
  xcd_barrier(xb);
  REP(3, phase_qkv(p, smem));
  REP(4, phase_spectra(p, smem));
  xcd_barrier(xb);
  REP(5, phase_attn(p, smem));
  REP(6, phase_hyena(p, smem));
  xcd_barrier(xb);
  REP(7, phase_out1(p, smem));
  xcd_barrier(xb);
  REP(8, phase_out2(p, smem));
}

extern "C" void kernel_launch(void* const* d_in, const int* in_sizes, int n_in, void* d_out, int out_size, void* d_ws, size_t ws_size, hipStream_t stream) {
  if (ws_size < WS_END) { fprintf(stderr, "kernel_launch: ws too small: %zu < %zu\n", ws_size, WS_END); return; }
  static int grid_blocks = 0;
  if (!grid_blocks) {
    int dev = 0, cus = 0, per_cu = 0;
    hipGetDevice(&dev);
    hipDeviceGetAttribute(&cus, hipDeviceAttributeMultiprocessorCount, dev);
    hipFuncSetAttribute((const void*)fwd_megakernel, hipFuncAttributeMaxDynamicSharedMemorySize, (int)LDS_BYTES);
    hipOccupancyMaxActiveBlocksPerMultiprocessor(&per_cu, fwd_megakernel, NT, LDS_BYTES);
    if (per_cu < 1) { fprintf(stderr, "kernel_launch: occupancy query returned %d\n", per_cu); return; }
    if (per_cu > 1) per_cu = 1;
    grid_blocks = cus * per_cu;
  }
  Params p{};
  const float** f = (const float**)&p;
  for (int i = 0; i < 23; ++i) f[i] = (const float*)d_in[i];
  p.out = (float*)d_out; p.ws = (char*)d_ws;
  hipMemsetAsync((char*)d_ws + OFF_BAR, 0, BAR_BYTES, stream);
  void* args[] = {&p};
  hipError_t e = hipLaunchCooperativeKernel((void*)fwd_megakernel, dim3(grid_blocks), dim3(NT), args, LDS_BYTES, stream);
  if (e != hipSuccess) fprintf(stderr, "cooperative launch failed: %s (grid %d)\n", hipGetErrorString(e), grid_blocks);
}
```

```cpp
#include <hip/hip_runtime.h>
#include <hip/hip_cooperative_groups.h>
#include <cstdio>
#include <cstdint>

typedef unsigned short bfr;
using bf16x8 = __attribute__((ext_vector_type(8))) short;
using f32x4  = __attribute__((ext_vector_type(4))) float;
using s16x4  = __attribute__((ext_vector_type(4))) short;
using f32x16 = __attribute__((ext_vector_type(16))) float;
using u32x4  = __attribute__((ext_vector_type(4))) unsigned;
using u32x2  = __attribute__((ext_vector_type(2))) unsigned;
#define SBAR() __builtin_amdgcn_sched_barrier(0)
__device__ __forceinline__ int otid() { int t = threadIdx.x; asm volatile("" : "+v"(t)); return t; }

#define XB_TMO      128
#define XB_XCNT(j)  (256  + 64 * (j))
#define XB_XSUB(j)  (1280 + 64 * (j))
#define XB_XGEN(j)  (2304 + 64 * (j))
#define XB_TOP      3328
#define XB_TOPGEN   3392
#define XCD_BAR_WORDS 3456
#define XB_SPIN_CAP (1u << 18)
#define LAS __attribute__((address_space(3)))
__device__ __forceinline__ unsigned xb_ld(unsigned* p)              { return __hip_atomic_load(p, __ATOMIC_RELAXED, __HIP_MEMORY_SCOPE_AGENT); }
__device__ __forceinline__ unsigned xb_add(unsigned* p, unsigned v) { return __hip_atomic_fetch_add(p, v, __ATOMIC_RELAXED, __HIP_MEMORY_SCOPE_AGENT); }
__device__ __forceinline__ unsigned xb_xcc_id() { return (unsigned)__builtin_amdgcn_s_getreg((3 << 11) | 20) & 0xFu; }
#define XB_SPIN(cond, bar) do { unsigned _sp = 0; while (cond) { __builtin_amdgcn_s_sleep(1); \
    if ((++_sp & 255u) == 0u) { if (xb_ld(&(bar)[XB_TMO])) break; if (_sp > XB_SPIN_CAP) { atomicAdd(&(bar)[XB_TMO], 1u); break; } } } } while (0)
struct XcdBarrier { unsigned* bar; unsigned x; volatile LAS unsigned* st; };
__device__ __forceinline__ XcdBarrier xcd_barrier_post(unsigned* bar, volatile LAS unsigned* st) {
  XcdBarrier b; b.bar = bar; b.x = xb_xcc_id(); b.st = st;
  if (threadIdx.x == 0) (void)xb_add(&bar[XB_XCNT(b.x)], 1u);
  return b;
}
__device__ __forceinline__ void xcd_barrier_complete(unsigned* bar, unsigned x, unsigned& nloc, unsigned& nx) {
  const unsigned G = gridDim.x * gridDim.y * gridDim.z;
  unsigned sum, cnt, mine, sp = 0u;
  for (;;) {
    sum = 0u; cnt = 0u; mine = 0u;
#pragma unroll
    for (unsigned j = 0; j < 16; ++j) { const unsigned c = xb_ld(&bar[XB_XCNT(j)]); sum += c; cnt += (c > 0u) ? 1u : 0u; mine = (j == x) ? c : mine; }
    if (sum == G) break;
    __builtin_amdgcn_s_sleep(1);
    if ((++sp & 255u) == 0u) { if (xb_ld(&bar[XB_TMO])) break; if (sp > XB_SPIN_CAP) { atomicAdd(&bar[XB_TMO], 1u); break; } }
  }
  nloc = mine > 0u ? mine : 1u; nx = cnt > 0u ? cnt : 1u;
}
__device__ __forceinline__ void xcd_barrier(const XcdBarrier& b) {
  asm volatile("s_waitcnt vmcnt(0)" ::: "memory");
  __syncthreads();
  if (threadIdx.x == 0) {
    unsigned* bar = b.bar;
    __builtin_amdgcn_s_waitcnt(0);
    unsigned nloc = b.st[0], nx = b.st[1];
    if (nloc == 0u) { xcd_barrier_complete(bar, b.x, nloc, nx); b.st[0] = nloc; b.st[1] = nx; }
    const unsigned old = xb_add(&bar[XB_XSUB(b.x)], 1u);
    const unsigned gen = old / nloc;
    if (old + 1u == (gen + 1u) * nloc) {
      __builtin_amdgcn_fence(__ATOMIC_RELEASE, "agent");
      asm volatile("s_waitcnt vmcnt(0)" ::: "memory");
      const unsigned og = xb_add(&bar[XB_TOP], 1u);
      const unsigned tg = og / nx;
      if (og + 1u == (tg + 1u) * nx) xb_add(&bar[XB_TOPGEN], 1u);
      else XB_SPIN(xb_ld(&bar[XB_TOPGEN]) == tg, bar);
      __builtin_amdgcn_fence(__ATOMIC_ACQUIRE, "agent");
      xb_add(&bar[XB_XGEN(b.x)], 1u);
      asm volatile("s_waitcnt vmcnt(0)" ::: "memory");
    } else {
      XB_SPIN(xb_ld(&bar[XB_XGEN(b.x)]) == gen, bar);
      __builtin_amdgcn_fence(__ATOMIC_ACQUIRE, "agent");
      asm volatile("s_waitcnt vmcnt(0)" ::: "memory");
    }
  }
  __syncthreads();
}
__device__ __forceinline__ int crow(int r, int hi) { return (r & 3) + 8 * (r >> 2) + 4 * hi; }
__device__ __forceinline__ unsigned cvtpk(float lo, float hi) { unsigned r; asm volatile("v_cvt_pk_bf16_f32 %0, %1, %2" : "=v"(r) : "v"(lo), "v"(hi)); return r; }

constexpr int NB = 8, L = 4096, DM = 1024, NTOK = NB * L;
constexpr int HY = 512, INC = 5280, INCP = 5376;
constexpr int P2W = 1184;
constexpr int P2_CQ = 0, P2_CKV = 384, P2_KR = 640, P2_ZA = 672;
constexpr int NH = 8, QKD = 96, KPAD = 128, VD = 64, QL = 384, KVL = 256;
constexpr float EPS = 1e-6f;
constexpr float PI_F = 3.14159265358979323846f;

constexpr size_t al256(size_t x) { return (x + 255) / 256 * 256; }
constexpr size_t PANEL = 256 * 1024 * 2;
constexpr size_t alpan(size_t x) { return (x + PANEL - 1) / PANEL * PANEL; }
constexpr size_t OFF_RSTD = 0;
constexpr size_t OFF_ROPE = OFF_RSTD + al256((size_t)NTOK * 4);
constexpr size_t OFF_H2   = OFF_ROPE + al256((size_t)L * 32 * 4);
constexpr size_t OFF_WIN  = alpan(OFF_H2 + al256((size_t)L * 64 * 4));
constexpr size_t OFF_WHY  = OFF_WIN + al256((size_t)INCP * DM * 2);
constexpr size_t OFF_WAT  = OFF_WHY + al256((size_t)DM * HY * 2);
constexpr size_t OFF_WOUT = OFF_WAT + al256((size_t)DM * HY * 2);
constexpr size_t OFF_HYT  = OFF_WOUT + al256((size_t)DM * DM * 2);
constexpr size_t OFF_P2   = OFF_HYT + al256((size_t)NB * 2048 * L * 2);
constexpr size_t OFF_Q    = alpan(OFF_P2 + al256((size_t)NTOK * P2W * 2));
constexpr size_t OFF_K    = OFF_Q + al256((size_t)NTOK * NH * QKD * 2);
constexpr size_t OFF_V    = OFF_K + al256((size_t)NTOK * NH * KPAD * 2);
constexpr size_t OFF_KS   = OFF_V + al256((size_t)NTOK * NH * VD * 2);
constexpr size_t OFF_AHY  = OFF_KS + al256((size_t)2 * HY * 16 * 512 * 8);
constexpr size_t OFF_AAT  = OFF_AHY + al256((size_t)NTOK * HY * 2);
constexpr size_t OFF_TW0  = OFF_AAT + al256((size_t)NTOK * HY * 2);
constexpr size_t OFF_TW1  = OFF_TW0 + al256((size_t)4096 * 8);
constexpr size_t OFF_TW2  = OFF_TW1 + al256((size_t)4096 * 8);
constexpr size_t OFF_WUQ  = OFF_TW2 + al256((size_t)256 * 8);
constexpr size_t OFF_WUKV = OFF_WUQ + al256((size_t)NH * QKD * QL * 2);
constexpr size_t OFF_BAR  = OFF_WUKV + al256((size_t)NH * 128 * KVL * 2);
constexpr size_t BAR_BYTES = 3456 * 4;
constexpr size_t WS_END   = OFF_BAR + al256(BAR_BYTES);
constexpr size_t OFF_KF   = OFF_AHY;
constexpr size_t OFF_XB   = OFF_Q;
constexpr size_t OFF_MRG  = OFF_HYT;

__device__ __forceinline__ bfr f2bf(float x) { unsigned u = __float_as_uint(x); u += 0x7fffu + ((u >> 16) & 1u); return (bfr)(u >> 16); }
__device__ __forceinline__ float bf2f(bfr h) { return __uint_as_float(((unsigned)h) << 16); }
__device__ __forceinline__ float sigmoidf_(float x) { return 1.f / (1.f + __expf(-x)); }
__device__ __forceinline__ float siluf_(float x) { return x / (1.f + __expf(-x)); }


namespace cg = cooperative_groups;
#define DUP 0
constexpr int NT = 512;
constexpr int FLD = 16 * 272;
constexpr size_t LDS_PHASE = 131072, LDS_BYTES = LDS_PHASE + 16;

struct Params {
  const float *x, *g_norm, *w_in, *b_gate, *w_short, *b_short, *w_f1, *b_f1, *freq1, *w_f2, *b_f2, *freq2, *w_f3, *hy_bias, *w_hy_out,
              *g_cq, *w_uq, *g_ckv, *w_ukv, *g_qn, *g_kn, *w_attn_out, *w_out;
  float* out; char* ws;
};

__device__ void wT_phase(const float* __restrict__ src, const float* __restrict__ scale, bfr* __restrict__ dst, int K, int N, int NP) {
  const int total = NP * (K / 32);
  for (int i = blockIdx.x * NT + threadIdx.x; i < total; i += gridDim.x * NT) {
    const int kb = i / NP, n = i - kb * NP;
    u32x4 o[4];
    if (n < N) {
      const float* s = src + (size_t)(kb * 32) * N + n;
      float v[32];
#pragma unroll
      for (int j = 0; j < 32; ++j) v[j] = s[(size_t)j * N];
      if (scale) {
#pragma unroll
        for (int j = 0; j < 32; ++j) v[j] *= scale[kb * 32 + j];
      }
#pragma unroll
      for (int j = 0; j < 4; ++j) o[j] = u32x4{cvtpk(v[8 * j], v[8 * j + 1]), cvtpk(v[8 * j + 2], v[8 * j + 3]), cvtpk(v[8 * j + 4], v[8 * j + 5]), cvtpk(v[8 * j + 6], v[8 * j + 7])};
    } else {
#pragma unroll
      for (int j = 0; j < 4; ++j) o[j] = u32x4{0u, 0u, 0u, 0u};
    }
    u32x4* d = (u32x4*)(dst + (size_t)n * K + kb * 32);
#pragma unroll
    for (int j = 0; j < 4; ++j) d[j] = o[j];
  }
}

__device__ void phase0(const Params& p, char* smem) {
  char* ws = p.ws;
  float* ROPE = (float*)(ws + OFF_ROPE); float* H2 = (float*)(ws + OFF_H2); float* RSTD = (float*)(ws + OFF_RSTD);
  bfr* XB = (bfr*)(ws + OFF_XB);
  const int tid = threadIdx.x, wid = tid >> 6, lane = tid & 63;
  for (int idx = blockIdx.x * NT + tid; idx < L * 16; idx += gridDim.x * NT) {
    int l = idx >> 4, j = idx & 15;
    float inv = powf(10000.f, -(float)(2 * j) / 32.f);
    float ang = (float)l * inv;
    ROPE[idx * 2] = cosf(ang); ROPE[idx * 2 + 1] = sinf(ang);
  }
  {
    float2* TW0 = (float2*)(ws + OFF_TW0); float2* TW1 = (float2*)(ws + OFF_TW1); float2* TW2 = (float2*)(ws + OFF_TW2);
    for (int idx = blockIdx.x * NT + tid; idx < 4096 + 4096 + 256; idx += gridDim.x * NT) {
      if (idx < 4096) { float a = (float)idx / 4096.f; TW0[idx] = make_float2(cospif(a), -sinpif(a)); }
      else if (idx < 8192) { int j = idx - 4096; int k1 = j >> 8, m = j & 255; float a = (float)((k1 * m) & 4095) / 2048.f; TW1[j] = make_float2(cospif(a), -sinpif(a)); }
      else { int j = idx - 8192; int k2 = j >> 4, n3 = j & 15; float a = (float)((k2 * n3) & 255) / 128.f; TW2[j] = make_float2(cospif(a), -sinpif(a)); }
    }
  }
  wT_phase(p.w_in, p.g_norm, (bfr*)(ws + OFF_WIN), DM, INC, INCP);
  wT_phase(p.w_hy_out, nullptr, (bfr*)(ws + OFF_WHY), HY, DM, DM);
  wT_phase(p.w_attn_out, nullptr, (bfr*)(ws + OFF_WAT), HY, DM, DM);
  wT_phase(p.w_out, nullptr, (bfr*)(ws + OFF_WOUT), DM, DM, DM);
  wT_phase(p.w_uq, p.g_cq, (bfr*)(ws + OFF_WUQ), QL, NH * QKD, NH * QKD);
  wT_phase(p.w_ukv, p.g_ckv, (bfr*)(ws + OFF_WUKV), KVL, NH * 128, NH * 128);
  {
    float* z = (float*)smem + wid * 128; float* h1 = z + 64;
    for (int it = blockIdx.x; it < L / 8; it += gridDim.x) {
      const int t = it * 8 + wid, j = lane;
      if (j < 33) {
        float v;
        if (j == 0) v = (float)t / (float)(L - 1);
        else { int i = (j - 1) & 15; float f = 1e-4f + (float)i * ((15.f - 1e-4f) / 15.f); float ang = ((2.f * PI_F / (float)L) * (float)t) * f;
               v = (j <= 16) ? cosf(ang) : -sinf(ang); }
        z[j] = v;
      }
      __syncthreads();
      float a = p.b_f1[j];
      for (int i = 0; i < 33; ++i) a += z[i] * p.w_f1[i * 64 + j];
      h1[j] = sinf(p.freq1[j] * a);
      __syncthreads();
      float c = p.b_f2[j];
      for (int i = 0; i < 64; ++i) c += h1[i] * p.w_f2[i * 64 + j];
      H2[t * 64 + j] = sinf(p.freq2[j] * c);
      __syncthreads();
    }
  }
  for (int row = blockIdx.x * 8 + wid; row < NTOK; row += gridDim.x * 8) {
    const float4* px = (const float4*)(p.x + (size_t)row * DM);
    float ss = 0.f;
    for (int i = 0; i < 4; ++i) {
      float4 v = px[lane + 64 * i];
      ss += v.x * v.x + v.y * v.y + v.z * v.z + v.w * v.w;
      ushort4 o; o.x = f2bf(v.x); o.y = f2bf(v.y); o.z = f2bf(v.z); o.w = f2bf(v.w);
      ((ushort4*)(XB + (size_t)row * DM))[lane + 64 * i] = o;
    }
    for (int off = 32; off > 0; off >>= 1) ss += __shfl_xor(ss, off);
    if (lane == 0) RSTD[row] = rsqrtf(ss / (float)DM + EPS);
  }
}

__device__ void phase_filt_k(const Params& p) {
  const float* H2 = (const float*)(p.ws + OFF_H2); float* KF = (float*)(p.ws + OFF_KF);
  const int tid = otid();
  for (int it = blockIdx.x; it < (L / 32) * 4; it += gridDim.x) {
    const int t0 = (it >> 2) * 32, col = (it & 3) * 512 + tid;
    const int o = col >> 10, dir = (col >> 9) & 1, c = col & 511;
    float acc[32];
#pragma unroll
    for (int tt = 0; tt < 32; ++tt) acc[tt] = 0.f;
    const float* h = H2 + t0 * 64;
#pragma unroll 2
    for (int j = 0; j < 64; ++j) {
      const float w = p.w_f3[j * 2048 + col];
#pragma unroll
      for (int tt = 0; tt < 32; ++tt) acc[tt] += h[tt * 64 + j] * w;
    }
    const float MIN_DECAY = -3.0701134573253944f, MAX_DECAY = -15.350567286626972f;
    const float delta = fabsf(MIN_DECAY + (MAX_DECAY - MIN_DECAY) * ((float)c / 511.f));
    float4* dst = (float4*)(KF + ((size_t)((o * 512 + c) * 2 + dir)) * L + t0);
#pragma unroll
    for (int q = 0; q < 8; ++q) {
      float4 v;
      v.x = acc[4 * q] * expf(-((float)(t0 + 4 * q) / (float)(L - 1)) * delta);
      v.y = acc[4 * q + 1] * expf(-((float)(t0 + 4 * q + 1) / (float)(L - 1)) * delta);
      v.z = acc[4 * q + 2] * expf(-((float)(t0 + 4 * q + 2) / (float)(L - 1)) * delta);
      v.w = acc[4 * q + 3] * expf(-((float)(t0 + 4 * q + 3) / (float)(L - 1)) * delta);
      dst[q] = v;
    }
  }
}

template <int N> __device__ __forceinline__ void wait_vm() { asm volatile("s_waitcnt vmcnt(%0)" :: "n"(N) : "memory"); }
template <int MI, int NI, int WM, int WN, bool SWAP>
__device__ __forceinline__ void gemm_main(const bfr* __restrict__ A, int lda, const bfr* __restrict__ Bt, int ldb, int nk  , char* smem, f32x16 (&acc)[MI][NI]) {
  constexpr int BM = 32 * MI * WM, BN = 32 * NI * WN, AB = BM * 64, STG = (BM + BN) * 64, CA = BM / 128, CB = BN / 128, G = CA + CB;
  static_assert(WM * WN == 8 && 4 * STG <= (int)LDS_PHASE && BM % 128 == 0 && BN % 128 == 0, "8 waves, four stages must fit");
  const int tid = otid(), wid = tid >> 6, lane = tid & 63, r32 = lane & 31, hi = lane >> 5, wm = wid / WN, wn = wid % WN;
  const int srow = tid >> 2, sc = (tid & 3) ^ ((tid >> 4) & 3);
  const int lp = r32 * 64 + ((hi ^ ((r32 >> 2) & 3)) << 4), aoff = wm * MI * 2048 + lp, boff = AB + wn * NI * 2048 + lp;
  const bfr* Ag = A + (size_t)srow * lda + sc * 8;
  const bfr* Bg = Bt + (size_t)srow * ldb + sc * 8;
  const int ldst = tid * 16;
#define ISSUE(kt) do { char* st_ = smem + ((kt) & 3) * STG; \
    _Pragma("unroll") for (int i = 0; i < CA; ++i) __builtin_amdgcn_global_load_lds((const unsigned*)(Ag + (size_t)i * 128 * lda + (kt) * 32), (LAS unsigned*)(st_ + i * 8192 + ldst), 16, 0, 0); \
    _Pragma("unroll") for (int i = 0; i < CB; ++i) __builtin_amdgcn_global_load_lds((const unsigned*)(Bg + (size_t)i * 128 * ldb + (kt) * 32), (LAS unsigned*)(st_ + AB + i * 8192 + ldst), 16, 0, 0); } while (0)
  __syncthreads();
  ISSUE(0); if (nk > 1) ISSUE(1); if (nk > 2) ISSUE(2);
  for (int kt = 0; kt < nk; ++kt) {
    const int rem = nk - 1 - kt;
    if (rem >= 2) wait_vm<2 * G>(); else if (rem == 1) wait_vm<G>(); else wait_vm<0>();
    __builtin_amdgcn_s_barrier();
    if (kt + 3 < nk) ISSUE(kt + 3);
    const char* st = smem + (kt & 3) * STG;
#pragma unroll
    for (int s = 0; s < 2; ++s) {
      bf16x8 a[MI], b[NI];
#pragma unroll
      for (int mi = 0; mi < MI; ++mi) a[mi] = *(const bf16x8*)(st + (aoff ^ (s << 5)) + mi * 2048);
#pragma unroll
      for (int ni = 0; ni < NI; ++ni) b[ni] = *(const bf16x8*)(st + (boff ^ (s << 5)) + ni * 2048);
#pragma unroll
      for (int mi = 0; mi < MI; ++mi)
#pragma unroll
        for (int ni = 0; ni < NI; ++ni)
          acc[mi][ni] = SWAP ? __builtin_amdgcn_mfma_f32_32x32x16_bf16(b[ni], a[mi], acc[mi][ni], 0, 0, 0)
                             : __builtin_amdgcn_mfma_f32_32x32x16_bf16(a[mi], b[ni], acc[mi][ni], 0, 0, 0);
    }
  }
#undef ISSUE
}

namespace pg8 {
#define PG8_LAS __attribute__((address_space(3)))
typedef unsigned short bf16_t;
constexpr int BM = 256, BK = 64, HALF = 128, HTB = HALF * BK * 2  , STAGE_BYTES = 8 * HTB, NXCD = 8, WGM = 8;

__host__ __device__ __forceinline__ int lds_byte(int r, int c) { const int st = (r >> 4) * 2 + (c >> 5), rr = r & 15, cc = c & 31, ob = rr * 64 + cc * 2; return st * 1024 + (ob ^ (((ob >> 9) & 1) << 5)); }
__host__ __device__ __forceinline__ void stage_rc(int b, int& R, int& C) { const int st = b / 1024, sb = b % 1024, swz = sb ^ (((sb >> 9) & 1) << 5); R = (st >> 1) * 16 + swz / 64; C = (st & 1) * 32 + (swz % 64) / 2; }
__host__ __device__ __forceinline__ int perm32(int rho) { const int n = rho >> 4, i = rho & 15; return 8 * (i >> 2) + 4 * n + (i & 3); }

struct Unit { int pm, pn; };
struct Gemm { const bf16_t* A; const bf16_t* Bt; int M, N, K; };
struct StaticOrder {
    int nM, nN, nwg, G, c;
    __host__ __device__ void init(int M, int N, int G_, int c_) { nM = M / BM; nN = N / BM; nwg = nM * nN; G = G_; c = c_; }
    __host__ __device__ bool next(int i, Unit& u) const {
        const long L = (long)i * G + c; if (L >= nwg) return false;
        int wgid = (int)L; { const int q = nwg / NXCD, r = nwg % NXCD, xcd = wgid % NXCD, off = wgid / NXCD; wgid = (xcd < r ? xcd * (q + 1) : r * (q + 1) + (xcd - r) * q) + off; }
        const int nig = WGM * nN, gid = wgid / nig, fm = gid * WGM, gsz = (nM - fm) < WGM ? (nM - fm) : WGM;
        u.pm = fm + ((wgid % nig) % gsz); u.pn = (wgid % nig) / gsz; return true;
    }
    __device__ __forceinline__ void a_ready(const Unit&) const {}
    __device__ __forceinline__ void done(const Unit&) const {}
};
template <class Epi, class Sched>
__device__ __forceinline__ void gemm_phase(PG8_LAS unsigned char* lds, const Gemm g, const Sched& S, const Epi& E) {
    const int tid = otid(), wid = __builtin_amdgcn_readfirstlane(tid >> 6), lane = tid & 63, wr = wid >> 2, wc = wid & 3, fr = lane & 15, fq = lane >> 4;
    const int K = g.K, nt = K / BK;
    unsigned voffA[2], voffB[2];
#pragma unroll
    for (int i = 0; i < 2; ++i) { int R, C; stage_rc(tid * 16 + i * 8192, R, C); const int Rb = Epi::PERM ? ((R & ~31) + perm32(R & 31)) : R;
        voffA[i] = (unsigned)(R * K + C) * 2u; voffB[i] = (unsigned)(Rb * K + C) * 2u; }
    const size_t kstep = (size_t)(BK * 2);
    const size_t hstep = (size_t)HALF * K * 2;
    const size_t tstep = 2 * hstep;
    const unsigned ldsw = (unsigned)wid * 1024u;
    const int aoff = lds_byte(wr * 64 + fr, fq * 8), boff = lds_byte(wc * 32 + fr, fq * 8);
#define PG8_SA(b, h) (((b) * 2 + (h)) * HTB)
#define PG8_SB(b, h) ((4 + (b) * 2 + (h)) * HTB)
#define PG8_STAGE(bufoff, gbase, voff) do { _Pragma("unroll") for (int _i = 0; _i < 2; ++_i) \
        __builtin_amdgcn_global_load_lds((const unsigned*)((const char*)(gbase) + (voff)[_i]), (PG8_LAS unsigned*)(lds + (bufoff) + ldsw + _i * 8192), 16, 0, 0); } while (0)
#define PG8_LDA(dst, b, h) do { _Pragma("unroll") for (int m = 0; m < 4; ++m) _Pragma("unroll") for (int k = 0; k < 2; ++k) dst[m][k] = *(const PG8_LAS bf16x8*)(lds + PG8_SA(b, h) + aoff + m * 2048 + k * 1024); } while (0)
#define PG8_LDB(dst, b, h) do { _Pragma("unroll") for (int n = 0; n < 2; ++n) _Pragma("unroll") for (int k = 0; k < 2; ++k) dst[n][k] = *(const PG8_LAS bf16x8*)(lds + PG8_SB(b, h) + boff + n * 2048 + k * 1024); } while (0)
#define PG8_MMA(ai, bj, At, Bt) do { __builtin_amdgcn_s_setprio(1); _Pragma("unroll") for (int m = 0; m < 4; ++m) _Pragma("unroll") for (int n = 0; n < 2; ++n) _Pragma("unroll") for (int k = 0; k < 2; ++k) \
        acc[ai][bj][m][n] = __builtin_amdgcn_mfma_f32_16x16x32_bf16(Bt[n][k], At[m][k], acc[ai][bj][m][n], 0, 0, 0); __builtin_amdgcn_s_setprio(0); } while (0)
#define PG8_WAIT_V(n) asm volatile("s_waitcnt vmcnt(" #n ")" ::: "memory")
#define PG8_WAIT_L(n) asm volatile("s_waitcnt lgkmcnt(" #n ")" ::: "memory")
#define PG8_BAR __builtin_amdgcn_s_barrier()
#define PG8_SCHED __builtin_amdgcn_sched_barrier(0)
    Unit cur, nxt; int ui = 0;
    if (!S.next(0, cur)) return;
    f32x4 acc[2][2][4][2];
#pragma unroll
    for (int a = 0; a < 2; ++a)
#pragma unroll
        for (int b = 0; b < 2; ++b)
#pragma unroll
            for (int m = 0; m < 4; ++m)
#pragma unroll
                for (int n = 0; n < 2; ++n) acc[a][b][m][n] = (f32x4){0.f, 0.f, 0.f, 0.f};
    bf16x8 At[4][2], B0[2][2], B1[2][2];
    const char* cA = (const char*)g.A + (size_t)cur.pm * tstep; const char* cB = (const char*)g.Bt + (size_t)cur.pn * tstep;
    S.a_ready(cur);
    PG8_STAGE(PG8_SB(0, 0), cB, voffB); PG8_STAGE(PG8_SA(0, 0), cA, voffA); PG8_STAGE(PG8_SB(0, 1), cB + hstep, voffB); PG8_STAGE(PG8_SA(0, 1), cA + hstep, voffA);
    if (wr == 1) PG8_BAR;
    PG8_WAIT_V(4); PG8_BAR;
    PG8_STAGE(PG8_SB(1, 0), cB + kstep, voffB); PG8_STAGE(PG8_SA(1, 0), cA + kstep, voffA); PG8_STAGE(PG8_SB(1, 1), cB + hstep + kstep, voffB);
    PG8_WAIT_V(6); PG8_BAR;
    for (;;) {
        const bool has_next = S.next(ui + 1, nxt);
        const char* nA = has_next ? (const char*)g.A + (size_t)nxt.pm * tstep : cA; const char* nB = has_next ? (const char*)g.Bt + (size_t)nxt.pn * tstep : cB;
        for (int t = 0; t < nt; t += 2) {
            const bool last = (t == nt - 2);
            const char* a1 = cA + (size_t)(t + 1) * kstep;
            const char* a2 = last ? nA : cA + (size_t)(t + 2) * kstep; const char* b2 = last ? nB : cB + (size_t)(t + 2) * kstep;
            const char* a3 = a2 + kstep; const char* b3 = b2 + kstep;
            if (last && has_next) S.a_ready(nxt);
            PG8_LDB(B0, 0, 0); PG8_SCHED; PG8_LDA(At, 0, 0); PG8_STAGE(PG8_SA(1, 1), a1 + hstep, voffA);
            PG8_WAIT_L(8); PG8_BAR; PG8_WAIT_L(0); PG8_MMA(0, 0, At, B0); PG8_BAR; PG8_SCHED;
            PG8_LDB(B1, 0, 1); PG8_STAGE(PG8_SB(0, 0), b2, voffB);
            PG8_BAR; PG8_WAIT_L(0); PG8_MMA(0, 1, At, B1); PG8_BAR;
            PG8_LDA(At, 0, 1); PG8_STAGE(PG8_SA(0, 0), a2, voffA);
            PG8_BAR; PG8_WAIT_L(0); PG8_MMA(1, 0, At, B0); PG8_BAR; PG8_SCHED;
            PG8_STAGE(PG8_SB(0, 1), b2 + hstep, voffB);
            PG8_WAIT_V(6); PG8_BAR; PG8_MMA(1, 1, At, B1); PG8_BAR;
            PG8_LDB(B0, 1, 0); PG8_SCHED; PG8_LDA(At, 1, 0); PG8_STAGE(PG8_SA(0, 1), a2 + hstep, voffA);
            PG8_WAIT_L(8); PG8_BAR; PG8_WAIT_L(0); PG8_MMA(0, 0, At, B0); PG8_BAR; PG8_SCHED;
            PG8_LDB(B1, 1, 1); PG8_STAGE(PG8_SB(1, 0), b3, voffB);
            PG8_BAR; PG8_WAIT_L(0); PG8_MMA(0, 1, At, B1); PG8_BAR;
            PG8_LDA(At, 1, 1); PG8_STAGE(PG8_SA(1, 0), a3, voffA);
            PG8_BAR; PG8_WAIT_L(0); PG8_MMA(1, 0, At, B0); PG8_BAR; PG8_SCHED;
            PG8_STAGE(PG8_SB(1, 1), b3 + hstep, voffB);
            PG8_WAIT_V(6); PG8_BAR; PG8_MMA(1, 1, At, B1); PG8_BAR;
        }
        if constexpr (!Epi::AFTER_DRAIN) { E(acc, cur, wr, wc, fr, fq); S.done(cur); }
        if (!has_next) break;
#pragma unroll
        for (int a = 0; a < 2; ++a)
#pragma unroll
            for (int b = 0; b < 2; ++b)
#pragma unroll
                for (int m = 0; m < 4; ++m)
#pragma unroll
                    for (int n = 0; n < 2; ++n) acc[a][b][m][n] = (f32x4){0.f, 0.f, 0.f, 0.f};
        cur = nxt; cA = nA; cB = nB; ++ui;
    }
    PG8_WAIT_V(0);
    if (wr == 0) PG8_BAR;
    PG8_BAR;
    if constexpr (Epi::AFTER_DRAIN) { E.fused(acc, cur, wr, wc, fr, fq, lds, wid, lane); S.done(cur); }
#undef PG8_SA
#undef PG8_SB
#undef PG8_STAGE
#undef PG8_LDA
#undef PG8_LDB
#undef PG8_MMA
#undef PG8_WAIT_V
#undef PG8_WAIT_L
#undef PG8_BAR
#undef PG8_SCHED
}
}


struct InprojOrder {
  pg8::StaticOrder so; int xbp, winp;
  __device__ __forceinline__ bool next(int i, pg8::Unit& u) const {
    pg8::Unit v; if (!so.next(i, v)) return false;
    if (v.pn < 8) { u.pm = winp + v.pn; u.pn = xbp + v.pm; } else { u.pm = xbp + v.pm; u.pn = winp + v.pn; }
    return true;
  }
  __device__ __forceinline__ void a_ready(const pg8::Unit&) const {}
  __device__ __forceinline__ void done(const pg8::Unit&) const {}
};
struct EpiInproj {
  static constexpr bool PERM = true, AFTER_DRAIN = false;
  const float* rstd; const float* b_gate; bfr* HYT; bfr* P2; bfr* GATES; int xbp, winp;
  __device__ __forceinline__ void operator()(const f32x4 (&acc)[2][2][4][2], const pg8::Unit& u, int wr, int wc, int fr, int fq) const {
    if (u.pm < xbp) {
      const int ch0 = (u.pm - winp) * 256 + wr * 64 + fr, tok0 = (u.pn - xbp) * 256 + wc * 32 + 8 * fq;
      const int b = tok0 >> 12, l0 = tok0 & 4095;
      f32x4 rs[2][2];
#pragma unroll
      for (int bj = 0; bj < 2; ++bj) { rs[bj][0] = *(const f32x4*)(rstd + tok0 + bj * 128); rs[bj][1] = *(const f32x4*)(rstd + tok0 + bj * 128 + 4); }
#pragma unroll
      for (int ai = 0; ai < 2; ++ai)
#pragma unroll
        for (int m = 0; m < 4; ++m) {
          bfr* rowp = HYT + ((size_t)(b * 2048 + ch0 + ai * 128 + m * 16)) * L + l0;
#pragma unroll
          for (int bj = 0; bj < 2; ++bj) {
            const f32x4 v0 = acc[ai][bj][m][0] * rs[bj][0], v1 = acc[ai][bj][m][1] * rs[bj][1];
            u32x4 w = {cvtpk(v0[0], v0[1]), cvtpk(v0[2], v0[3]), cvtpk(v1[0], v1[1]), cvtpk(v1[2], v1[3])};
            *(u32x4*)(rowp + bj * 128) = w;
          }
        }
    } else {
      const int row0 = (u.pm - xbp) * 256 + wr * 64 + fr, c0 = (u.pn - winp) * 256 + wc * 32 + 8 * fq;
#pragma unroll
      for (int bj = 0; bj < 2; ++bj) {
        const int c = c0 + bj * 128;
        if (c < 3232) {
#pragma unroll
          for (int ai = 0; ai < 2; ++ai)
#pragma unroll
            for (int m = 0; m < 4; ++m) {
              const int row = row0 + ai * 128 + m * 16; const float rs = rstd[row];
              const f32x4 v0 = acc[ai][bj][m][0] * rs, v1 = acc[ai][bj][m][1] * rs;
              u32x4 w = {cvtpk(v0[0], v0[1]), cvtpk(v0[2], v0[3]), cvtpk(v1[0], v1[1]), cvtpk(v1[2], v1[3])};
              *(u32x4*)(P2 + (size_t)row * P2W + (c - 2048)) = w;
            }
        } else if (c < INC) {
          const f32x4 b0 = *(const f32x4*)(b_gate + (c - 3232)), b1 = *(const f32x4*)(b_gate + (c - 3232) + 4);
#pragma unroll
          for (int ai = 0; ai < 2; ++ai)
#pragma unroll
            for (int m = 0; m < 4; ++m) {
              const int row = row0 + ai * 128 + m * 16; const float rs = rstd[row];
              const f32x4 v0 = acc[ai][bj][m][0] * rs + b0, v1 = acc[ai][bj][m][1] * rs + b1;
              u32x4 w = {cvtpk(sigmoidf_(v0[0]), sigmoidf_(v0[1])), cvtpk(sigmoidf_(v0[2]), sigmoidf_(v0[3])), cvtpk(sigmoidf_(v1[0]), sigmoidf_(v1[1])), cvtpk(sigmoidf_(v1[2]), sigmoidf_(v1[3]))};
              *(u32x4*)(GATES + (size_t)row * 2048 + (c - 3232)) = w;
            }
        }
      }
    }
  }
};
__device__ void phase_inproj8(const Params& p, char* smem) {
  static_assert(OFF_XB % PANEL == 0 && OFF_WIN % PANEL == 0 && OFF_WIN + 21 * PANEL <= OFF_XB, "operand panels must sit on panel boundaries of the workspace");
  char* ws = p.ws;
  __syncthreads();
  pg8::Gemm g{(const bfr*)ws, (const bfr*)ws, NTOK, INCP, DM};
  InprojOrder S; S.so.init(NTOK, INCP, (int)gridDim.x, (int)blockIdx.x); S.xbp = (int)(OFF_XB / PANEL); S.winp = (int)(OFF_WIN / PANEL);
  EpiInproj E{(const float*)(ws + OFF_RSTD), p.b_gate, (bfr*)(ws + OFF_HYT), (bfr*)(ws + OFF_P2), (bfr*)p.out, S.xbp, S.winp};
  pg8::gemm_phase((PG8_LAS unsigned char*)smem, g, S, E);
}
struct EpiOut2 {
  static constexpr bool PERM = false, AFTER_DRAIN = false;
  const float* x; float* out;
  __device__ __forceinline__ void operator()(const f32x4 (&acc)[2][2][4][2], const pg8::Unit& u, int wr, int wc, int fr, int fq) const {
    const int row0 = u.pm * 256 + wr * 64 + fr, col0 = u.pn * 256 + wc * 32 + 4 * fq;
#pragma unroll
    for (int ai = 0; ai < 2; ++ai)
#pragma unroll
      for (int m = 0; m < 4; ++m) {
        const size_t off = (size_t)(row0 + ai * 128 + m * 16) * DM + col0;
#pragma unroll
        for (int bj = 0; bj < 2; ++bj)
#pragma unroll
          for (int n = 0; n < 2; ++n) { const size_t o = off + bj * 128 + n * 16; *(f32x4*)(out + o) = *(const f32x4*)(x + o) + acc[ai][bj][m][n]; }
      }
  }
};
__device__ void phase_out2_8(const Params& p, char* smem) {
  char* ws = p.ws;
  __syncthreads();
  pg8::Gemm g{(const bfr*)(ws + OFF_MRG), (const bfr*)(ws + OFF_WOUT), NTOK, DM, DM};
  pg8::StaticOrder S; S.init(NTOK, DM, (int)gridDim.x, (int)blockIdx.x);
  EpiOut2 E{p.x, p.out};
  pg8::gemm_phase((PG8_LAS unsigned char*)smem, g, S, E);
}

__device__ void phase_inproj(const Params& p, char* smem) {
  char* ws = p.ws;
  const bfr* XB = (const bfr*)(ws + OFF_XB); const bfr* WIN = (const bfr*)(ws + OFF_WIN); const float* rstd = (const float*)(ws + OFF_RSTD);
  bfr* HYT = (bfr*)(ws + OFF_HYT); bfr* P2 = (bfr*)(ws + OFF_P2); bfr* GATES = (bfr*)p.out;
  const int tid_ = otid(), wid = tid_ >> 6, lane = tid_ & 63, r32 = lane & 31, hi = lane >> 5, wm = wid >> 2, wn = wid & 3;
  constexpr int NTN = INCP / 256, NTM = NTOK / 256;
  for (int it = blockIdx.x; it < NTN * NTM; it += gridDim.x) {
    const int tn = it % NTN, tm = it / NTN, m0 = tm * 256, n0 = tn * 256;
    f32x16 acc[4][2];
#pragma unroll
    for (int mi = 0; mi < 4; ++mi)
#pragma unroll
      for (int ni = 0; ni < 2; ++ni) acc[mi][ni] = f32x16{};
    if (n0 < 2048) {
      gemm_main<4, 2, 2, 4, false>(XB + (size_t)m0 * DM, DM, WIN + (size_t)n0 * DM, DM, DM / 32, smem, acc);
      const int b = m0 >> 12, l0 = (m0 & 4095) + wm * 128 + 4 * hi;
#pragma unroll
      for (int mi = 0; mi < 4; ++mi) {
#pragma unroll
        for (int g = 0; g < 4; ++g) {
          const float4 rs = *(const float4*)(rstd + m0 + wm * 128 + mi * 32 + 8 * g + 4 * hi);
#pragma unroll
          for (int ni = 0; ni < 2; ++ni) {
            bfr* dst = HYT + ((size_t)(b * 2048 + n0 + wn * 64 + ni * 32 + r32)) * L + l0 + mi * 32 + 8 * g;
            u32x2 w = {cvtpk(acc[mi][ni][4 * g] * rs.x, acc[mi][ni][4 * g + 1] * rs.y), cvtpk(acc[mi][ni][4 * g + 2] * rs.z, acc[mi][ni][4 * g + 3] * rs.w)};
            *(u32x2*)dst = w;
          }
        }
      }
    } else {
      gemm_main<4, 2, 2, 4, true>(XB + (size_t)m0 * DM, DM, WIN + (size_t)n0 * DM, DM, DM / 32, smem, acc);
#pragma unroll
      for (int mi = 0; mi < 4; ++mi) {
        const int m = m0 + wm * 128 + mi * 32 + r32;
        const float rs = rstd[m];
#pragma unroll
        for (int ni = 0; ni < 2; ++ni) {
          const int nc = n0 + wn * 64 + ni * 32;
          if (nc < 3232) {
            bfr* dst = P2 + (size_t)m * P2W + (nc - 2048) + 4 * hi;
#pragma unroll
            for (int g = 0; g < 4; ++g) {
              u32x2 w = {cvtpk(acc[mi][ni][4 * g] * rs, acc[mi][ni][4 * g + 1] * rs), cvtpk(acc[mi][ni][4 * g + 2] * rs, acc[mi][ni][4 * g + 3] * rs)};
              *(u32x2*)(dst + 8 * g) = w;
            }
          } else if (nc < INC) {
            bfr* dst = GATES + (size_t)m * 2048 + (nc - 3232) + 4 * hi;
            const float* bgp = p.b_gate + (nc - 3232) + 4 * hi;
#pragma unroll
            for (int g = 0; g < 4; ++g) {
              const float4 bg = *(const float4*)(bgp + 8 * g);
              u32x2 w = {cvtpk(sigmoidf_(acc[mi][ni][4 * g] * rs + bg.x), sigmoidf_(acc[mi][ni][4 * g + 1] * rs + bg.y)),
                         cvtpk(sigmoidf_(acc[mi][ni][4 * g + 2] * rs + bg.z), sigmoidf_(acc[mi][ni][4 * g + 3] * rs + bg.w))};
              *(u32x2*)(dst + 8 * g) = w;
            }
          }
        }
      }
    }
  }
}

__device__ __forceinline__ float swap_add(float x) {
  auto rr = __builtin_amdgcn_permlane32_swap(__float_as_uint(x), __float_as_uint(x), false, false);
  return __uint_as_float(rr[0]) + __uint_as_float(rr[1]);
}
template <int N8> __device__ __forceinline__ float sumsq_bf16(const bfr* __restrict__ p) {
  float s = 0.f;
#pragma unroll 4
  for (int i = 0; i < N8; ++i) {
    const u32x4 v = *(const u32x4*)(p + 8 * i);
#pragma unroll
    for (int j = 0; j < 4; ++j) { const float a = __uint_as_float(v[j] << 16), b = __uint_as_float(v[j] & 0xffff0000u); s += a * a + b * b; }
  }
  return s;
}
__device__ void phase_qkv(const Params& p, char* smem) {
  char* ws = p.ws;
  const bfr* P2 = (const bfr*)(ws + OFF_P2); const float* rope = (const float*)(ws + OFF_ROPE);
  const bfr* WUQ = (const bfr*)(ws + OFF_WUQ); const bfr* WUKV = (const bfr*)(ws + OFF_WUKV);
  bfr* Q = (bfr*)(ws + OFF_Q); bfr* K = (bfr*)(ws + OFF_K); bfr* V = (bfr*)(ws + OFF_V);
  const int tid_ = otid(), wid = tid_ >> 6, lane = tid_ & 63, r32 = lane & 31, hi = lane >> 5;
  constexpr int NQ = (NTOK / 128) * 2, NKV = (NTOK / 256) * 4;
  for (int it = blockIdx.x; it < NQ; it += gridDim.x) {
    {
      const int tn = it & 1, tm = it >> 1, m0 = tm * 128, wm = wid >> 2, wn = wid & 3, head = tn * 4 + wn;
      f32x16 acc[2][3];
#pragma unroll
      for (int mi = 0; mi < 2; ++mi)
#pragma unroll
        for (int ni = 0; ni < 3; ++ni) acc[mi][ni] = f32x16{};
      float rsv[2];
#pragma unroll
      for (int mi = 0; mi < 2; ++mi)
        rsv[mi] = rsqrtf(swap_add(sumsq_bf16<24>(P2 + (size_t)(m0 + wm * 64 + mi * 32 + r32) * P2W + P2_CQ + hi * 192)) / (float)QL + EPS);
      SBAR();
      gemm_main<2, 3, 2, 4, true>(P2 + (size_t)m0 * P2W + P2_CQ, P2W, WUQ + (size_t)tn * 384 * QL, QL, QL / 32, smem, acc);
#pragma unroll
      for (int mi = 0; mi < 2; ++mi) {
        SBAR();
        int hi4 = 4 * hi; asm volatile("" : "+v"(hi4));
        const int tok = m0 + wm * 64 + mi * 32 + r32, b = tok >> 12, l = tok & 4095;
        const float rs = rsv[mi];
        float s2 = 0.f;
#pragma unroll
        for (int ni = 0; ni < 3; ++ni)
#pragma unroll
          for (int r = 0; r < 16; ++r) { const float v = acc[mi][ni][r] * rs; acc[mi][ni][r] = v; s2 += v * v; }
        const float r2 = rsqrtf(swap_add(s2) / (float)QKD + EPS);
#pragma unroll
        for (int ni = 0; ni < 3; ++ni)
#pragma unroll
          for (int g = 0; g < 4; ++g) {
            const float4 gg = *(const float4*)(p.g_qn + ni * 32 + 8 * g + hi4);
            acc[mi][ni][4 * g] *= r2 * gg.x; acc[mi][ni][4 * g + 1] *= r2 * gg.y; acc[mi][ni][4 * g + 2] *= r2 * gg.z; acc[mi][ni][4 * g + 3] *= r2 * gg.w;
          }
#pragma unroll
        for (int r = 0; r < 8; ++r) {
          const float2 cs = *(const float2*)(rope + (l * 16 + crow(r, hi)) * 2);
          const float t1 = acc[mi][2][r], t2 = acc[mi][2][r + 8];
          acc[mi][2][r] = t1 * cs.x - t2 * cs.y; acc[mi][2][r + 8] = t1 * cs.y + t2 * cs.x;
        }
        bfr* q = Q + ((size_t)((b * NH + head) * L + l)) * QKD + 4 * hi;
#pragma unroll
        for (int ni = 0; ni < 3; ++ni)
#pragma unroll
          for (int g = 0; g < 4; ++g) {
            u32x2 w = {cvtpk(acc[mi][ni][4 * g], acc[mi][ni][4 * g + 1]), cvtpk(acc[mi][ni][4 * g + 2], acc[mi][ni][4 * g + 3])};
            *(u32x2*)(q + ni * 32 + 8 * g) = w;
          }
      }
    }
  }
  for (int i2 = blockIdx.x; i2 < NKV; i2 += gridDim.x) {
    {
      const int tn = i2 & 3, tm = i2 >> 2, m0 = tm * 256, wm = wid >> 1, wn = wid & 1, head = tn * 2 + wn;
      f32x16 acc[2][4];
#pragma unroll
      for (int mi = 0; mi < 2; ++mi)
#pragma unroll
        for (int ni = 0; ni < 4; ++ni) acc[mi][ni] = f32x16{};
      float rsv[2];
#pragma unroll
      for (int mi = 0; mi < 2; ++mi)
        rsv[mi] = rsqrtf(swap_add(sumsq_bf16<16>(P2 + (size_t)(m0 + wm * 64 + mi * 32 + r32) * P2W + P2_CKV + hi * 128)) / (float)KVL + EPS);
      SBAR();
      gemm_main<2, 4, 4, 2, true>(P2 + (size_t)m0 * P2W + P2_CKV, P2W, WUKV + (size_t)tn * 256 * KVL, KVL, KVL / 32, smem, acc);
#pragma unroll
      for (int mi = 0; mi < 2; ++mi) {
        SBAR();
        int hi4 = 4 * hi; asm volatile("" : "+v"(hi4));
        const int tok = m0 + wm * 64 + mi * 32 + r32, b = tok >> 12, l = tok & 4095;
        const bfr* prow = P2 + (size_t)tok * P2W;
        const float rs = rsv[mi];
        float kr[16];
#pragma unroll
        for (int g = 0; g < 4; ++g) {
          const u32x2 w = *(const u32x2*)(prow + P2_KR + 8 * g + 4 * hi);
          kr[4 * g] = __uint_as_float(w[0] << 16); kr[4 * g + 1] = __uint_as_float(w[0] & 0xffff0000u);
          kr[4 * g + 2] = __uint_as_float(w[1] << 16); kr[4 * g + 3] = __uint_as_float(w[1] & 0xffff0000u);
        }
        float s2 = 0.f;
#pragma unroll
        for (int ni = 0; ni < 4; ++ni)
#pragma unroll
          for (int r = 0; r < 16; ++r) { const float v = acc[mi][ni][r] * rs; acc[mi][ni][r] = v; if (ni < 2) s2 += v * v; }
#pragma unroll
        for (int r = 0; r < 16; ++r) s2 += kr[r] * kr[r];
        const float r2 = rsqrtf(swap_add(s2) / (float)QKD + EPS);
#pragma unroll
        for (int ni = 0; ni < 2; ++ni)
#pragma unroll
          for (int g = 0; g < 4; ++g) {
            const float4 gg = *(const float4*)(p.g_kn + ni * 32 + 8 * g + hi4);
            acc[mi][ni][4 * g] *= r2 * gg.x; acc[mi][ni][4 * g + 1] *= r2 * gg.y; acc[mi][ni][4 * g + 2] *= r2 * gg.z; acc[mi][ni][4 * g + 3] *= r2 * gg.w;
          }
#pragma unroll
        for (int g = 0; g < 4; ++g) {
          const float4 gg = *(const float4*)(p.g_kn + 64 + 8 * g + hi4);
          kr[4 * g] *= r2 * gg.x; kr[4 * g + 1] *= r2 * gg.y; kr[4 * g + 2] *= r2 * gg.z; kr[4 * g + 3] *= r2 * gg.w;
        }
#pragma unroll
        for (int r = 0; r < 8; ++r) {
          const float2 cs = *(const float2*)(rope + (l * 16 + crow(r, hi)) * 2);
          const float t1 = kr[r], t2 = kr[r + 8];
          kr[r] = t1 * cs.x - t2 * cs.y; kr[r + 8] = t1 * cs.y + t2 * cs.x;
        }
        bfr* kp = K + ((size_t)((b * NH + head) * L + l)) * KPAD + 4 * hi;
#pragma unroll
        for (int ni = 0; ni < 2; ++ni)
#pragma unroll
          for (int g = 0; g < 4; ++g) {
            u32x2 w = {cvtpk(acc[mi][ni][4 * g], acc[mi][ni][4 * g + 1]), cvtpk(acc[mi][ni][4 * g + 2], acc[mi][ni][4 * g + 3])};
            *(u32x2*)(kp + ni * 32 + 8 * g) = w;
          }
#pragma unroll
        for (int g = 0; g < 4; ++g) {
          u32x2 w = {cvtpk(kr[4 * g], kr[4 * g + 1]), cvtpk(kr[4 * g + 2], kr[4 * g + 3])};
          *(u32x2*)(kp + 64 + 8 * g) = w;
        }
        bfr* vp = V + ((size_t)((b * NH + head) * L + l)) * VD + 4 * hi;
#pragma unroll
        for (int ni = 2; ni < 4; ++ni)
#pragma unroll
          for (int g = 0; g < 4; ++g) {
            u32x2 w = {cvtpk(acc[mi][ni][4 * g], acc[mi][ni][4 * g + 1]), cvtpk(acc[mi][ni][4 * g + 2], acc[mi][ni][4 * g + 3])};
            *(u32x2*)(vp + (ni - 2) * 32 + 8 * g) = w;
          }
      }
    }
  }
}

constexpr int AT_SHM_V = 64 * VD * 2, AT_SHM_K = 64 * KPAD * 2;
constexpr float AT_SCALE = 0.10206207261596575f;
constexpr float AT_THR = 8.f;
#define KSWZ(row, colB) ((row) * 256 + ((colB) ^ (((row) & 7) << 4)))
__device__ __forceinline__ void partialSM(f32x16& p0, f32x16& p1, float& m_reg, float& mn, float& alpha) {
  constexpr float C = AT_SCALE * 1.4426950408889634f;
  float pmax = p0[0];
#pragma unroll
  for (int r = 1; r < 16; ++r) pmax = fmaxf(pmax, p0[r]);
#pragma unroll
  for (int r = 0; r < 16; ++r) pmax = fmaxf(pmax, p1[r]);
  { auto rr = __builtin_amdgcn_permlane32_swap(__float_as_uint(pmax), __float_as_uint(pmax), false, false);
    pmax = fmaxf(__uint_as_float(rr[0]), __uint_as_float(rr[1])); }
  if (__builtin_expect(__all(pmax - m_reg <= AT_THR / AT_SCALE), 1)) { mn = m_reg; alpha = 1.f; }
  else { mn = fmaxf(m_reg, pmax); alpha = __builtin_amdgcn_exp2f((m_reg - mn) * C); m_reg = mn; }
  float mnC = -mn * C;
#pragma unroll
  for (int r = 0; r < 16; ++r) p0[r] = fmaf(p0[r], C, mnC);
#pragma unroll
  for (int r = 0; r < 16; ++r) p1[r] = fmaf(p1[r], C, mnC);
#pragma unroll
  for (int r = 0; r < 16; ++r) p0[r] = __builtin_amdgcn_exp2f(p0[r]);
}
__device__ __forceinline__ void finishSM(f32x16& p0, f32x16& p1, float alpha, float& l_reg, bf16x8& pa0, bf16x8& pa1, bf16x8& pa2, bf16x8& pa3) {
#pragma unroll
  for (int r = 0; r < 16; ++r) p1[r] = __builtin_amdgcn_exp2f(p1[r]);
  float ps = 0;
#pragma unroll
  for (int r = 0; r < 16; ++r) ps += p0[r];
#pragma unroll
  for (int r = 0; r < 16; ++r) ps += p1[r];
  { auto rr = __builtin_amdgcn_permlane32_swap(__float_as_uint(ps), __float_as_uint(ps), false, false);
    ps = __uint_as_float(rr[0]) + __uint_as_float(rr[1]); }
  l_reg = l_reg * alpha + ps;
#define PK4(P, BASE, OUT) do { unsigned a0 = cvtpk(P[BASE + 0], P[BASE + 1]), a1 = cvtpk(P[BASE + 2], P[BASE + 3]);   \
    unsigned b0 = cvtpk(P[BASE + 4], P[BASE + 5]), b1 = cvtpk(P[BASE + 6], P[BASE + 7]);                              \
    auto r0 = __builtin_amdgcn_permlane32_swap(a0, b0, false, false); auto r1 = __builtin_amdgcn_permlane32_swap(a1, b1, false, false); \
    u32x4 w = {r0[0], r1[0], r0[1], r1[1]}; OUT = *reinterpret_cast<bf16x8*>(&w); } while (0)
  PK4(p0, 0, pa0); PK4(p0, 8, pa1); PK4(p1, 0, pa2); PK4(p1, 8, pa3);
#undef PK4
}
__device__ __forceinline__ void qkt(f32x16& p0, f32x16& p1, const char* Ks, const bf16x8* qr, int r32, int hi) {
  p0 = f32x16{}; p1 = f32x16{};
#pragma unroll
  for (int d0 = 0; d0 < 6; ++d0) { int cb = (d0 * 16 + hi * 8) * 2;
    bf16x8 b0 = *reinterpret_cast<const bf16x8*>(Ks + KSWZ(r32, cb));
    bf16x8 b1 = *reinterpret_cast<const bf16x8*>(Ks + KSWZ(32 + r32, cb));
    p0 = __builtin_amdgcn_mfma_f32_32x32x16_bf16(b0, qr[d0], p0, 0, 0, 0);
    p1 = __builtin_amdgcn_mfma_f32_32x32x16_bf16(b1, qr[d0], p1, 0, 0, 0); }
}
__device__ __forceinline__ int v_st(int k, int c) { const int kk = (k & ~0xC) | ((k & 4) << 1) | ((k & 8) >> 1); return ((kk >> 3) * 2 + (c >> 5)) * 512 + ((kk & 7) * 32 + (c & 31)) * 2; }
__device__ __forceinline__ int v_rd_base(int lane) { return ((lane & 3) << 3) | (((lane >> 2) & 3) << 6) | (((lane >> 4) & 1) << 5) | (((lane >> 5) & 1) << 8); }
constexpr int v_rd_off(int d0, int ks, int half) { return d0 * 512 + ks * 2048 + half * 1024; }
template <int OFF> __device__ __forceinline__ s16x4 tr_read(int vb) {
  s16x4 r; asm volatile("ds_read_b64_tr_b16 %0, %1 offset:%2" : "=&v"(r) : "v"(vb), "i"(OFF) : "memory"); return r;
}
template <int D0> __device__ __forceinline__ void pv_one(f32x16& od, int vb, bf16x8 pa0, bf16x8 pa1, bf16x8 pa2, bf16x8 pa3) {
  const s16x4 l0 = tr_read<v_rd_off(D0, 0, 0)>(vb), h0 = tr_read<v_rd_off(D0, 0, 1)>(vb), l1 = tr_read<v_rd_off(D0, 1, 0)>(vb), h1 = tr_read<v_rd_off(D0, 1, 1)>(vb);
  const s16x4 l2 = tr_read<v_rd_off(D0, 2, 0)>(vb), h2 = tr_read<v_rd_off(D0, 2, 1)>(vb), l3 = tr_read<v_rd_off(D0, 3, 0)>(vb), h3 = tr_read<v_rd_off(D0, 3, 1)>(vb);
  asm volatile("s_waitcnt lgkmcnt(0)" ::: "memory"); SBAR();
#define PK(LL, HH) (bf16x8){LL[0], LL[1], LL[2], LL[3], HH[0], HH[1], HH[2], HH[3]}
  od = __builtin_amdgcn_mfma_f32_32x32x16_bf16(pa0, PK(l0, h0), od, 0, 0, 0);
  od = __builtin_amdgcn_mfma_f32_32x32x16_bf16(pa1, PK(l1, h1), od, 0, 0, 0);
  od = __builtin_amdgcn_mfma_f32_32x32x16_bf16(pa2, PK(l2, h2), od, 0, 0, 0);
  od = __builtin_amdgcn_mfma_f32_32x32x16_bf16(pa3, PK(l3, h3), od, 0, 0, 0);
#undef PK
}
__device__ __forceinline__ void pv_d0(f32x16* o, int vb, bf16x8 pa0, bf16x8 pa1, bf16x8 pa2, bf16x8 pa3) {
  pv_one<0>(o[0], vb, pa0, pa1, pa2, pa3); pv_one<1>(o[1], vb, pa0, pa1, pa2, pa3);
}
__device__ __forceinline__ void attn_body(const bfr* __restrict__ Qb, const bfr* __restrict__ Kh, const bfr* __restrict__ Vh,
                                          const bfr* __restrict__ za, bfr* __restrict__ op, char* lds) {
  const int tid = otid(), wid = tid >> 6, lane = tid & 63, r32 = lane & 31, hi = lane >> 5;
  char* V_lds = lds; char* K_lds = lds + 2 * AT_SHM_V;
  float* wsm = (float*)(lds + 2 * AT_SHM_V + 2 * AT_SHM_K) + wid * 64; float* li_l = wsm; float* al_l = wsm + 32;
  float m_reg = -1e30f, l_reg = 0; f32x16 o[2] = {}; bf16x8 qr[6];
  const bfr* Qw = Qb + (long)(wid * 32 + r32) * QKD + hi * 8;
#pragma unroll
  for (int d0 = 0; d0 < 6; ++d0) qr[d0] = *reinterpret_cast<const bf16x8*>(Qw + d0 * 16);
  const int sr = tid >> 4, sc = (tid & 15) * 8, vr = tid >> 3, vc = (tid & 7) * 8, vst0 = v_st(vr, vc);
  const int vb0 = (int)(uintptr_t)V_lds + v_rd_base(lane);
  struct { bf16x8 vs0, ks0, ks1; } sr_[2];
#define SLOAD(i, k0) do { sr_[i].vs0 = *reinterpret_cast<const bf16x8*>(&Vh[(long)((k0) + vr) * VD + vc]); \
    sr_[i].ks0 = *reinterpret_cast<const bf16x8*>(&Kh[(long)((k0) + sr) * KPAD + sc]); sr_[i].ks1 = *reinterpret_cast<const bf16x8*>(&Kh[(long)((k0) + 32 + sr) * KPAD + sc]); } while (0)
#define SWRITE(b, i) do { *(bf16x8*)(V_lds + (b) * AT_SHM_V + vst0) = sr_[i].vs0; int kc = sc * 2;               \
    *(bf16x8*)(K_lds + (b) * AT_SHM_K + KSWZ(sr, kc)) = sr_[i].ks0;                       \
    *(bf16x8*)(K_lds + (b) * AT_SHM_K + KSWZ(32 + sr, kc)) = sr_[i].ks1; } while (0)
#define SWAIT() asm volatile("s_waitcnt vmcnt(3)" ::: "memory")
#define RESC(a) do { if (__any((a) < 1.f)) { if (hi == 0) al_l[r32] = (a); asm volatile("s_waitcnt lgkmcnt(0)" ::: "memory"); \
    for (int d = 0; d < 2; ++d) for (int r = 0; r < 16; ++r) o[d][r] *= al_l[crow(r, hi)]; } } while (0)
  f32x16 pA0, pA1, pB0, pB1; float mnA, mnB, alA, alB; bf16x8 pa0, pa1, pa2, pa3; constexpr int NTL = L / 64;
  constexpr int SE = 0, SO = 1;
  SLOAD(SE, 0); asm volatile("s_waitcnt vmcnt(0)" ::: "memory"); SWRITE(0, SE); __syncthreads();
  qkt(pA0, pA1, K_lds, qr, r32, hi); partialSM(pA0, pA1, m_reg, mnA, alA);
  SLOAD(SO, 64); SLOAD(SE, 128);
  SWAIT(); SWRITE(1, SO); __syncthreads();
  for (int j = 1; j + 1 < NTL; j += 2) {
    SBAR(); qkt(pB0, pB1, K_lds + AT_SHM_K, qr, r32, hi);
    finishSM(pA0, pA1, alA, l_reg, pa0, pa1, pa2, pa3); SBAR();
    SLOAD(SO, (j + 2) * 64); SBAR();
    pv_d0(o, vb0, pa0, pa1, pa2, pa3); partialSM(pB0, pB1, m_reg, mnB, alB);
    __syncthreads(); SWAIT(); SWRITE(0, SE);
    RESC(alB); __syncthreads();
    SBAR(); qkt(pA0, pA1, K_lds, qr, r32, hi);
    finishSM(pB0, pB1, alB, l_reg, pa0, pa1, pa2, pa3); SBAR();
    if (j + 3 < NTL) SLOAD(SE, (j + 3) * 64); SBAR();
    pv_d0(o, vb0 + AT_SHM_V, pa0, pa1, pa2, pa3); partialSM(pA0, pA1, m_reg, mnA, alA);
    __syncthreads(); SWAIT(); SWRITE(1, SO);
    RESC(alA); __syncthreads();
  }
  SBAR(); qkt(pB0, pB1, K_lds + AT_SHM_K, qr, r32, hi);
  finishSM(pA0, pA1, alA, l_reg, pa0, pa1, pa2, pa3); SBAR();
  pv_d0(o, vb0, pa0, pa1, pa2, pa3); partialSM(pB0, pB1, m_reg, mnB, alB);
  __syncthreads(); RESC(alB);
  finishSM(pB0, pB1, alB, l_reg, pa0, pa1, pa2, pa3); SBAR();
  pv_d0(o, vb0 + AT_SHM_V, pa0, pa1, pa2, pa3);
  if (hi == 0) li_l[r32] = l_reg; asm volatile("s_waitcnt lgkmcnt(0)" ::: "memory");
  float rli[16];
#pragma unroll
  for (int r = 0; r < 16; ++r) rli[r] = __builtin_amdgcn_rcpf(li_l[crow(r, hi)]);
  int row0 = wid * 32 + 4 * hi; asm volatile("" : "+v"(row0));
  const bfr* zr = za + row0 * P2W + r32; bfr* orp = op + row0 * HY + r32;
#pragma unroll
  for (int r = 0; r < 16; ++r) { const int ro = (r & 3) + 8 * (r >> 2);
#pragma unroll
    for (int d0 = 0; d0 < 2; ++d0) {
      const float z = bf2f(zr[ro * P2W + d0 * 32]);
      orp[ro * HY + d0 * 32] = f2bf(o[d0][r] * rli[r] * siluf_(z)); } }
#undef SLOAD
#undef SWRITE
#undef SWAIT
#undef RESC
}
__device__ void phase_attn(const Params& p, char* smem) {
  char* ws = p.ws;
  const bfr* Q = (const bfr*)(ws + OFF_Q); const bfr* K = (const bfr*)(ws + OFF_K); const bfr* V = (const bfr*)(ws + OFF_V);
  const bfr* P2 = (const bfr*)(ws + OFF_P2); bfr* AAT = (bfr*)(ws + OFF_AAT);
  constexpr int NQB = L / 256, NIT = NQB * NB * NH;
  for (int it = blockIdx.x; it < NIT; it += gridDim.x) {
    const int bh = it / NQB, qb = it % NQB, b = bh >> 3, h = bh & 7;
    const size_t tok0 = (size_t)b * L + qb * 256;
    __syncthreads();
    attn_body(Q + ((size_t)bh * L + qb * 256) * QKD, K + (size_t)bh * L * KPAD, V + (size_t)bh * L * VD,
              P2 + tok0 * P2W + P2_ZA + h * VD, AAT + tok0 * HY + h * VD, smem);
  }
}

__device__ __forceinline__ float2 cmul(float2 a, float2 b) { return make_float2(a.x * b.x - a.y * b.y, a.x * b.y + a.y * b.x); }
__device__ __forceinline__ float2 cmulc(float2 a, float2 b) { return make_float2(a.x * b.x + a.y * b.y, a.y * b.x - a.x * b.y); }
__device__ __forceinline__ constexpr int br4(int r) { return ((r & 1) << 3) | ((r & 2) << 1) | ((r & 4) >> 1) | ((r & 8) >> 3); }
template <bool INV> __device__ __forceinline__ float2 tw16(float2 v, int j) {
  const float C1 = 0.92387953251128674f, S1 = 0.38268343236508977f, R = 0.70710678118654752f;
  float c, s;
  switch (j) { case 0: return v;
    case 1: c = C1; s = S1; break; case 2: c = R; s = R; break; case 3: c = S1; s = C1; break;
    case 4: return INV ? make_float2(-v.y, v.x) : make_float2(v.y, -v.x);
    case 5: c = -S1; s = C1; break; case 6: c = -R; s = R; break; default: c = -C1; s = S1; break; }
  if (INV) s = -s;
  return make_float2(v.x * c + v.y * s, v.y * c - v.x * s);
}
__device__ __forceinline__ void fft16_dif(float2 (&a)[16]) {
#pragma unroll
  for (int s = 0; s < 4; ++s) {
    const int half = 8 >> s;
#pragma unroll
    for (int start = 0; start < 16; start += 2 * half) {
#pragma unroll
      for (int j = 0; j < half; ++j) {
        float2 u = a[start + j], v = a[start + j + half];
        a[start + j] = make_float2(u.x + v.x, u.y + v.y);
        a[start + j + half] = tw16<false>(make_float2(u.x - v.x, u.y - v.y), j * (8 / half));
      }
    }
  }
}
__device__ __forceinline__ void ifft16_dit(float2 (&a)[16]) {
#pragma unroll
  for (int s = 3; s >= 0; --s) {
    const int half = 8 >> s;
#pragma unroll
    for (int start = 0; start < 16; start += 2 * half) {
#pragma unroll
      for (int j = 0; j < half; ++j) {
        float2 pp = a[start + j], q = tw16<true>(a[start + j + half], j * (8 / half));
        a[start + j] = make_float2(pp.x + q.x, pp.y + q.y);
        a[start + j + half] = make_float2(pp.x - q.x, pp.y - q.y);
      }
    }
  }
}
__device__ __forceinline__ void hy_fwd(float2* lds, const float2* __restrict__ TW1, const float2* __restrict__ TW2, float2 (&a)[16]) {
  const int tid = threadIdx.x, m = tid & 255, k1 = m >> 4, lo = m & 15;
  float2* base = lds + (tid >> 8) * FLD;
#pragma unroll
  for (int n = 0; n < 16; ++n) a[n] = base[n * 272 + m];
  fft16_dif(a);
#pragma unroll
  for (int r = 0; r < 16; ++r) { const int k = br4(r); base[k * 272 + m] = cmul(a[r], TW1[k * 272 + m]); }
  __syncthreads();
#pragma unroll
  for (int n = 0; n < 16; ++n) a[n] = base[k1 * 272 + n * 16 + lo];
  fft16_dif(a);
  __syncthreads();
#pragma unroll
  for (int r = 0; r < 16; ++r) { const int k = br4(r); base[k1 * 272 + lo * 17 + k] = cmul(a[r], TW2[k * 16 + lo]); }
  __syncthreads();
#pragma unroll
  for (int n = 0; n < 16; ++n) a[n] = base[k1 * 272 + n * 17 + lo];
  fft16_dif(a);
}
__device__ __forceinline__ void hy_inv(float2* lds, const float2* __restrict__ TW1, const float2* __restrict__ TW2, float2 (&a)[16]) {
  const int tid = threadIdx.x, m = tid & 255, k1 = m >> 4, lo = m & 15;
  float2* base = lds + (tid >> 8) * FLD;
  ifft16_dit(a);
#pragma unroll
  for (int n = 0; n < 16; ++n) base[k1 * 272 + n * 17 + lo] = cmulc(a[n], TW2[n * 16 + lo]);
  __syncthreads();
#pragma unroll
  for (int r = 0; r < 16; ++r) a[r] = base[k1 * 272 + lo * 17 + br4(r)];
  ifft16_dit(a);
  __syncthreads();
#pragma unroll
  for (int n = 0; n < 16; ++n) base[k1 * 272 + n * 16 + lo] = cmulc(a[n], TW1[k1 * 272 + 16 * n + lo]);
  __syncthreads();
#pragma unroll
  for (int r = 0; r < 16; ++r) a[r] = base[br4(r) * 272 + m];
  ifft16_dit(a);
#pragma unroll
  for (int n = 0; n < 16; ++n) base[n * 272 + m] = a[n];
  __syncthreads();
}

__device__ __forceinline__ void hy_load_tw(char* smem, const float2* __restrict__ gTW1, const float2* __restrict__ gTW2) {
  float2* t1 = (float2*)(smem + 2 * FLD * 8); float2* t2 = t1 + 16 * 272;
  for (int i = threadIdx.x; i < 4096; i += NT) t1[(i >> 8) * 272 + (i & 255)] = gTW1[i];
  if (threadIdx.x < 256) t2[threadIdx.x] = gTW2[threadIdx.x];
  __syncthreads();
}
__device__ void phase_spectra(const Params& p, char* smem) {
  char* ws = p.ws;
  const float* KF = (const float*)(ws + OFF_KF); float2* KS = (float2*)(ws + OFF_KS);
  const float2* TW0 = (const float2*)(ws + OFF_TW0);
  float2* lds = (float2*)smem;
  const float2* TW1 = lds + 2 * FLD; const float2* TW2 = TW1 + 16 * 272;
  __syncthreads();
  hy_load_tw(smem, (const float2*)(ws + OFF_TW1), (const float2*)(ws + OFF_TW2));
  const int tid = threadIdx.x;
  for (int it = blockIdx.x; it < 2 * HY; it += gridDim.x) {
    const float* kf = KF + (size_t)it * 2 * L;
    __syncthreads();
#pragma unroll
    for (int j = 0; j < 8; ++j) {
      const int i = tid + NT * j, pos = (i >> 8) * 272 + (i & 255);
      const float lo = kf[i], hi = kf[L + (L - 1 - i)];
      lds[pos] = make_float2(lo + hi, 0.f);
      const float2 w = TW0[i]; const float d = lo - hi;
      lds[FLD + pos] = make_float2(d * w.x, d * w.y);
    }
    __syncthreads();
    float2 a[16];
    hy_fwd(lds, TW1, TW2, a);
    float2* ks = KS + (size_t)it * 16 * NT;
#pragma unroll
    for (int r = 0; r < 16; ++r) ks[r * NT + tid] = make_float2(a[r].x * (1.f / 8192.f), a[r].y * (1.f / 8192.f));
  }
}

__device__ __forceinline__ void sconv8(const bfr* __restrict__ seq, int tid, float w0, float w1, float w2, float bb, float (&u)[8]) {
  const bfr* s = seq + 8 * tid;
  const uint4 raw = *(const uint4*)s;
  float in[10];
  in[0] = tid > 0 ? bf2f(s[-1]) : 0.f; in[9] = tid < NT - 1 ? bf2f(s[8]) : 0.f;
  in[1] = __uint_as_float(raw.x << 16); in[2] = __uint_as_float(raw.x & 0xffff0000u);
  in[3] = __uint_as_float(raw.y << 16); in[4] = __uint_as_float(raw.y & 0xffff0000u);
  in[5] = __uint_as_float(raw.z << 16); in[6] = __uint_as_float(raw.z & 0xffff0000u);
  in[7] = __uint_as_float(raw.w << 16); in[8] = __uint_as_float(raw.w & 0xffff0000u);
#pragma unroll
  for (int j = 0; j < 8; ++j) u[j] = w0 * in[j] + w1 * in[j + 1] + w2 * in[j + 2] + bb;
}
__device__ __forceinline__ void ld8bf(const bfr* __restrict__ seq, int tid, float (&u)[8]) {
  const uint4 raw = *(const uint4*)(seq + 8 * tid);
  u[0] = __uint_as_float(raw.x << 16); u[1] = __uint_as_float(raw.x & 0xffff0000u);
  u[2] = __uint_as_float(raw.y << 16); u[3] = __uint_as_float(raw.y & 0xffff0000u);
  u[4] = __uint_as_float(raw.z << 16); u[5] = __uint_as_float(raw.z & 0xffff0000u);
  u[6] = __uint_as_float(raw.w << 16); u[7] = __uint_as_float(raw.w & 0xffff0000u);
}
struct Raw8 { u32x4 v; unsigned pn; };
__device__ __forceinline__ Raw8 load_raw8(const bfr* __restrict__ seq, int tid) {
  const bfr* s = seq + 8 * tid; Raw8 r;
  r.v = *(const u32x4*)s;
  const unsigned pv = tid > 0 ? (unsigned)s[-1] : 0u, nx = tid < NT - 1 ? (unsigned)s[8] : 0u;
  r.pn = pv | (nx << 16);
  return r;
}
__device__ __forceinline__ void sconv8_raw(const Raw8& r, float w0, float w1, float w2, float bb, float (&u)[8]) {
  float in[10];
  in[0] = __uint_as_float(r.pn << 16); in[9] = __uint_as_float(r.pn & 0xffff0000u);
  in[1] = __uint_as_float(r.v[0] << 16); in[2] = __uint_as_float(r.v[0] & 0xffff0000u);
  in[3] = __uint_as_float(r.v[1] << 16); in[4] = __uint_as_float(r.v[1] & 0xffff0000u);
  in[5] = __uint_as_float(r.v[2] << 16); in[6] = __uint_as_float(r.v[2] & 0xffff0000u);
  in[7] = __uint_as_float(r.v[3] << 16); in[8] = __uint_as_float(r.v[3] & 0xffff0000u);
#pragma unroll
  for (int j = 0; j < 8; ++j) u[j] = w0 * in[j] + w1 * in[j + 1] + w2 * in[j + 2] + bb;
}
__device__ __forceinline__ void hy_scatter(float2* lds, const float2* __restrict__ TW0, const float2 (&z)[8]) {
  const int tid = threadIdx.x, pos = (tid >> 5) * 272 + 8 * (tid & 31);
  const float4* tw = (const float4*)(TW0 + 8 * tid);
#pragma unroll
  for (int j = 0; j < 4; ++j) {
    const float4 w = tw[j];
    *(float4*)(lds + pos + 2 * j) = make_float4(z[2 * j].x, z[2 * j].y, z[2 * j + 1].x, z[2 * j + 1].y);
    const float2 o0 = cmul(z[2 * j], make_float2(w.x, w.y)), o1 = cmul(z[2 * j + 1], make_float2(w.z, w.w));
    *(float4*)(lds + FLD + pos + 2 * j) = make_float4(o0.x, o0.y, o1.x, o1.y);
  }
}
__device__ __forceinline__ void hy_gather(const float2* lds, const float2* __restrict__ TW0, float2 (&y)[8]) {
  const int tid = threadIdx.x, pos = (tid >> 5) * 272 + 8 * (tid & 31);
  const float4* tw = (const float4*)(TW0 + 8 * tid);
#pragma unroll
  for (int j = 0; j < 4; ++j) {
    const float4 w = tw[j];
    const float4 e = *(const float4*)(lds + pos + 2 * j), o = *(const float4*)(lds + FLD + pos + 2 * j);
    const float2 t0 = cmulc(make_float2(o.x, o.y), make_float2(w.x, w.y)), t1 = cmulc(make_float2(o.z, o.w), make_float2(w.z, w.w));
    y[2 * j] = make_float2(e.x + t0.x, e.y + t0.y); y[2 * j + 1] = make_float2(e.z + t1.x, e.w + t1.y);
  }
}
__device__ void phase_hyena(const Params& p, char* smem) {
  char* ws = p.ws;
  const bfr* HYT = (const bfr*)(ws + OFF_HYT); const float2* KS = (const float2*)(ws + OFF_KS); bfr* AHY = (bfr*)(ws + OFF_AHY);
  const float2* TW0 = (const float2*)(ws + OFF_TW0);
  float2* lds = (float2*)smem;
  const float2* TW1 = lds + 2 * FLD; const float2* TW2 = TW1 + 16 * 272;
  __syncthreads();
  hy_load_tw(smem, (const float2*)(ws + OFF_TW1), (const float2*)(ws + OFF_TW2));
  const int tid = threadIdx.x;
  for (int n = 0;; ++n) {
    const int c = blockIdx.x + gridDim.x * (n >> 2), bp = n & 3;
    if (c >= HY) break;
    const int b0 = 2 * bp, b1 = b0 + 1;
    float2 zin[8];
    {
      float u0[8], u1[8];
      const float w0 = p.w_short[c], w1 = p.w_short[1536 + c], w2 = p.w_short[3072 + c], bb = p.b_short[c];
      sconv8(HYT + ((size_t)(b0 * 2048 + c)) * L, tid, w0, w1, w2, bb, u0);
      sconv8(HYT + ((size_t)(b1 * 2048 + c)) * L, tid, w0, w1, w2, bb, u1);
#pragma unroll
      for (int j = 0; j < 8; ++j) zin[j] = make_float2(u0[j], u1[j]);
      __syncthreads();
      hy_scatter(lds, TW0, zin);
      __syncthreads();
    }
#pragma unroll 1
    for (int o = 0; o < 2; ++o) {
      const int chg = (o == 0 ? 512 : 1024) + c;
      const Raw8 rg0 = load_raw8(HYT + ((size_t)(b0 * 2048 + chg)) * L, tid), rg1 = load_raw8(HYT + ((size_t)(b1 * 2048 + chg)) * L, tid);
      {
        float2 a[16], ksr[16];
        const float2* ks = KS + (size_t)(o * HY + c) * 16 * NT;
#pragma unroll
        for (int r = 0; r < 16; ++r) ksr[r] = ks[r * NT + tid];
        SBAR();
        hy_fwd(lds, TW1, TW2, a);
#pragma unroll
        for (int r = 0; r < 16; ++r) a[r] = cmul(a[r], ksr[r]);
        hy_inv(lds, TW1, TW2, a);
      }
      __builtin_amdgcn_sched_barrier(0);
      float2 y[8];
      hy_gather(lds, TW0, y);
      const float w0 = p.w_short[chg], w1 = p.w_short[1536 + chg], w2 = p.w_short[3072 + chg], bb = p.b_short[chg];
      const float bias = p.hy_bias[o * HY + c];
      float g0[8], g1[8];
      sconv8_raw(rg0, w0, w1, w2, bb, g0);
      sconv8_raw(rg1, w0, w1, w2, bb, g1);
#pragma unroll
      for (int j = 0; j < 8; ++j) zin[j] = make_float2(g0[j] * (y[j].x + bias * zin[j].x), g1[j] * (y[j].y + bias * zin[j].y));
      __syncthreads();
      if (o == 0) {
        hy_scatter(lds, TW0, zin);
        __syncthreads();
      } else {
        const u32x4 rz0 = *(const u32x4*)(HYT + ((size_t)(b0 * 2048 + 1536 + c)) * L + 8 * tid), rz1 = *(const u32x4*)(HYT + ((size_t)(b1 * 2048 + 1536 + c)) * L + 8 * tid);
#pragma unroll
        for (int j = 0; j < 8; ++j) {
          const int i = 8 * tid + j;
          const float z0 = (j & 1) ? __uint_as_float(rz0[j >> 1] & 0xffff0000u) : __uint_as_float(rz0[j >> 1] << 16);
          const float z1 = (j & 1) ? __uint_as_float(rz1[j >> 1] & 0xffff0000u) : __uint_as_float(rz1[j >> 1] << 16);
          AHY[((size_t)(b0 * L + i)) * HY + c] = f2bf(zin[j].x * siluf_(z0));
          AHY[((size_t)(b1 * L + i)) * HY + c] = f2bf(zin[j].y * siluf_(z1));
        }
      }
    }
  }
}

__device__ void phase_out1(const Params& p, char* smem) {
  char* ws = p.ws;
  const bfr* AHY = (const bfr*)(ws + OFF_AHY); const bfr* AAT = (const bfr*)(ws + OFF_AAT); const bfr* WHY = (const bfr*)(ws + OFF_WHY); const bfr* WAT = (const bfr*)(ws + OFF_WAT);
  const bfr* GATES = (const bfr*)p.out; bfr* MRG = (bfr*)(ws + OFF_MRG);
  const int tid_ = otid(), wid = tid_ >> 6, lane = tid_ & 63, r32 = lane & 31, hi = lane >> 5, wm = wid >> 2, wn = wid & 3;
  constexpr int NTN = DM / 128, NTM = NTOK / 256;
  for (int it = blockIdx.x; it < NTN * NTM; it += gridDim.x) {
    const int tn = it % NTN, tm = it / NTN, m0 = tm * 256, n0 = tn * 128;
    f32x16 a1[4][1], a2[4][1];
#pragma unroll
    for (int mi = 0; mi < 4; ++mi) { a1[mi][0] = f32x16{}; a2[mi][0] = f32x16{}; }
    gemm_main<4, 1, 2, 4, true>(AHY + (size_t)m0 * HY, HY, WHY + (size_t)n0 * HY, HY, HY / 32, smem, a1);
    gemm_main<4, 1, 2, 4, true>(AAT + (size_t)m0 * HY, HY, WAT + (size_t)n0 * HY, HY, HY / 32, smem, a2);
    const int c4 = n0 + wn * 32 + 4 * hi;
#pragma unroll
    for (int mi = 0; mi < 4; ++mi) {
      const size_t m = m0 + wm * 128 + mi * 32 + r32;
#pragma unroll
      for (int g = 0; g < 4; ++g) {
        const u32x2 gh = *(const u32x2*)(GATES + m * 2048 + c4 + 8 * g), ga = *(const u32x2*)(GATES + m * 2048 + 1024 + c4 + 8 * g);
        const float h0 = __uint_as_float(gh[0] << 16), h1 = __uint_as_float(gh[0] & 0xffff0000u), h2 = __uint_as_float(gh[1] << 16), h3 = __uint_as_float(gh[1] & 0xffff0000u);
        const float t0 = __uint_as_float(ga[0] << 16), t1 = __uint_as_float(ga[0] & 0xffff0000u), t2 = __uint_as_float(ga[1] << 16), t3 = __uint_as_float(ga[1] & 0xffff0000u);
        u32x2 w = {cvtpk(h0 * a1[mi][0][4 * g] + t0 * a2[mi][0][4 * g], h1 * a1[mi][0][4 * g + 1] + t1 * a2[mi][0][4 * g + 1]),
                   cvtpk(h2 * a1[mi][0][4 * g + 2] + t2 * a2[mi][0][4 * g + 2], h3 * a1[mi][0][4 * g + 3] + t3 * a2[mi][0][4 * g + 3])};
        *(u32x2*)(MRG + m * DM + c4 + 8 * g) = w;
      }
    }
  }
}
__device__ void phase_out2(const Params& p, char* smem) {
  char* ws = p.ws;
  const bfr* MRG = (const bfr*)(ws + OFF_MRG); const bfr* WOUT = (const bfr*)(ws + OFF_WOUT);
  const int tid_ = otid(), wid = tid_ >> 6, lane = tid_ & 63, r32 = lane & 31, hi = lane >> 5, wm = wid >> 2, wn = wid & 3;
  constexpr int NTN = DM / 256, NTM = NTOK / 256;
  for (int it = blockIdx.x; it < NTN * NTM; it += gridDim.x) {
    const int tn = it % NTN, tm = it / NTN, m0 = tm * 256, n0 = tn * 256;
    f32x16 acc[4][2];
#pragma unroll
    for (int mi = 0; mi < 4; ++mi)
#pragma unroll
      for (int ni = 0; ni < 2; ++ni) acc[mi][ni] = f32x16{};
    gemm_main<4, 2, 2, 4, true>(MRG + (size_t)m0 * DM, DM, WOUT + (size_t)n0 * DM, DM, DM / 32, smem, acc);
#pragma unroll
    for (int mi = 0; mi < 4; ++mi)
#pragma unroll
      for (int ni = 0; ni < 2; ++ni) {
        const size_t off = (size_t)(m0 + wm * 128 + mi * 32 + r32) * DM + n0 + wn * 64 + ni * 32 + 4 * hi;
#pragma unroll
        for (int g = 0; g < 4; ++g) {
          const float4 xv = *(const float4*)(p.x + off + 8 * g);
          float4 o; o.x = xv.x + acc[mi][ni][4 * g]; o.y = xv.y + acc[mi][ni][4 * g + 1]; o.z = xv.z + acc[mi][ni][4 * g + 2]; o.w = xv.w + acc[mi][ni][4 * g + 3];
          *(float4*)(p.out + off + 8 * g) = o;
        }
      }
  }
}

__global__ __launch_bounds__(NT, 1) void fwd_megakernel(Params p) {
  extern __shared__ __attribute__((aligned(16))) char smem[];
  cg::grid_group grid = cg::this_grid();
#define REP(n, stmt) { int nrep_ = (DUP == (n) ? 2 : 1); asm volatile("" : "+s"(nrep_)); _Pragma("unroll 1") for (int rep_ = 0; rep_ < nrep_; ++rep_) { stmt; } }
  volatile LAS unsigned* xst = (volatile LAS unsigned*)(smem + LDS_PHASE);
  if (threadIdx.x == 0) { xst[0] = 0u; xst[1] = 0u; }
  __syncthreads();
  XcdBarrier xb = xcd_barrier_post((unsigned*)(p.ws + OFF_BAR), xst);
  REP(1, phase0(p, smem));
  grid.sync();
  phase_filt_k(p);
  REP(2, phase_inproj8(p, smem));
  xcd_barrier(xb);
  REP(3, phase_qkv(p, smem));
  REP(4, phase_spectra(p, smem));
  xcd_barrier(xb);
  REP(5, phase_attn(p, smem));
  REP(6, phase_hyena(p, smem));
  xcd_barrier(xb);
  REP(7, phase_out1(p, smem));
  xcd_barrier(xb);
  REP(8, phase_out2_8(p, smem));
}

extern "C" void kernel_launch(void* const* d_in, const int* in_sizes, int n_in, void* d_out, int out_size, void* d_ws, size_t ws_size, hipStream_t stream) {
  if (ws_size < WS_END) { fprintf(stderr, "kernel_launch: ws too small: %zu < %zu\n", ws_size, WS_END); return; }
  static int grid_blocks = 0;
  if (!grid_blocks) {
    int dev = 0, cus = 0, per_cu = 0;
    hipGetDevice(&dev);
    hipDeviceGetAttribute(&cus, hipDeviceAttributeMultiprocessorCount, dev);
    hipFuncSetAttribute((const void*)fwd_megakernel, hipFuncAttributeMaxDynamicSharedMemorySize, (int)LDS_BYTES);
    hipOccupancyMaxActiveBlocksPerMultiprocessor(&per_cu, fwd_megakernel, NT, LDS_BYTES);
    if (per_cu < 1) { fprintf(stderr, "kernel_launch: occupancy query returned %d\n", per_cu); return; }
    if (per_cu > 1) per_cu = 1;
    grid_blocks = cus * per_cu;
  }
  Params p{};
  const float** f = (const float**)&p;
  for (int i = 0; i < 23; ++i) f[i] = (const float*)d_in[i];
  p.out = (float*)d_out; p.ws = (char*)d_ws;
  hipMemsetAsync((char*)d_ws + OFF_BAR, 0, BAR_BYTES, stream);
  void* args[] = {&p};
  hipError_t e = hipLaunchCooperativeKernel((void*)fwd_megakernel, dim3(grid_blocks), dim3(NT), args, LDS_BYTES, stream);
  if (e != hipSuccess) fprintf(stderr, "cooperative launch failed: %s (grid %d)\n", hipGetErrorString(e), grid_blocks);
}
```
